# Optimizing an MI355X kernel written in HIP

```python
import math
import jax, jax.numpy as jnp
from jax import lax
import numpy as np

D_MODEL = 1024
BATCH = 4
SEQ = 8192
DEPTH = 1

MLSTM_HEADS = 4
MLSTM_WIDTH = D_MODEL
MLSTM_HEAD_DIM = MLSTM_WIDTH // MLSTM_HEADS
MLSTM_CHUNK = 128
CONV_WIDTH = 4
S5_WIDTH = D_MODEL // 2
S5_GROUP = 16
S5_GROUPS = S5_WIDTH // S5_GROUP
S5_STATE = 64
DT_MIN = 0.001
DT_MAX = 0.1
N_BRANCHES = 2
NORM_EPS = 1e-6
IN_TOTAL = 3 * MLSTM_WIDTH + 2 * MLSTM_HEADS + 2 * S5_WIDTH + N_BRANCHES * D_MODEL

kernel_name = "hybrid_mlstm_s5_gated_block"


def _split_points():
    sizes = (MLSTM_WIDTH, MLSTM_WIDTH, MLSTM_WIDTH, MLSTM_HEADS, MLSTM_HEADS,
             S5_WIDTH, S5_WIDTH, N_BRANCHES * D_MODEL)
    return [int(s) for s in np.cumsum(sizes)[:-1]]


def rmsnorm(x, g):
    xf = x.astype(jnp.float32)
    y = xf * lax.rsqrt(jnp.mean(xf * xf, axis=-1, keepdims=True) + NORM_EPS)
    return (y * g.astype(jnp.float32)).astype(x.dtype)


def causal_dwconv(u, w, b):
    K, C = w.shape
    y = lax.conv_general_dilated(u, w[:, None, :].astype(u.dtype), window_strides=(1,),
                                 padding=[(K - 1, 0)], dimension_numbers=('NWC', 'WIO', 'NWC'),
                                 feature_group_count=C)
    return y + b.astype(u.dtype)


def mlstm_chunkwise(q, k, v, ig, lf):
    Bsz, H, L, dh = q.shape
    Lc = MLSTM_CHUNK
    NC = L // Lc
    q = q.reshape(Bsz, H, NC, Lc, dh)
    k = k.reshape(Bsz, H, NC, Lc, dh) * (dh ** -0.5)
    v = v.reshape(Bsz, H, NC, Lc, dh)
    ig = ig.reshape(Bsz, H, NC, Lc)
    b = jnp.cumsum(lf.reshape(Bsz, H, NC, Lc), axis=-1)
    b_last = b[..., -1]
    w_end = b_last[..., None] - b + ig
    m_loc = jnp.max(w_end, axis=-1)
    e_end = jnp.exp(w_end - m_loc[..., None])
    C_loc = jnp.einsum('bhcs,bhcsd,bhcse->bhcde', e_end, v, k)
    n_loc = jnp.einsum('bhcs,bhcse->bhce', e_end, k)

    def step(carry, inp):
        C, n, m = carry
        C_l, n_l, m_l, bl = inp
        m_new = jnp.maximum(bl + m, m_l)
        a = jnp.exp(bl + m - m_new)
        s = jnp.exp(m_l - m_new)
        C_new = a[..., None, None] * C + s[..., None, None] * C_l
        n_new = a[..., None] * n + s[..., None] * n_l
        return (C_new, n_new, m_new), (C, n, m)

    init = (jnp.zeros((Bsz, H, dh, dh), jnp.float32), jnp.zeros((Bsz, H, dh), jnp.float32),
            jnp.full((Bsz, H), -jnp.inf, jnp.float32))
    xs = (jnp.moveaxis(C_loc, 2, 0), jnp.moveaxis(n_loc, 2, 0),
          jnp.moveaxis(m_loc, 2, 0), jnp.moveaxis(b_last, 2, 0))
    _, (C_prev, n_prev, m_prev) = lax.scan(step, init, xs)
    C_prev = jnp.moveaxis(C_prev, 0, 2)
    n_prev = jnp.moveaxis(n_prev, 0, 2)
    m_prev = jnp.moveaxis(m_prev, 0, 2)

    causal = jnp.tril(jnp.ones((Lc, Lc), dtype=bool))
    log_d = jnp.where(causal, b[..., :, None] - b[..., None, :] + ig[..., None, :], -jnp.inf)
    log_inter = b + m_prev[..., None]
    m_t = jnp.maximum(log_inter, jnp.max(log_d, axis=-1))
    dmat = jnp.exp(log_d - m_t[..., None])
    inter = jnp.exp(log_inter - m_t)
    s = jnp.einsum('bhctd,bhcsd->bhcts', q, k) * dmat
    num = jnp.einsum('bhcts,bhcsd->bhctd', s, v) + inter[..., None] * jnp.einsum('bhcde,bhcte->bhctd', C_prev, q)
    den = jnp.sum(s, axis=-1) + inter * jnp.einsum('bhce,bhcte->bhct', n_prev, q)
    h = num / jnp.maximum(jnp.abs(den), jnp.exp(-m_t))[..., None]
    return h.reshape(Bsz, H, L, dh)


def mlstm_branch(u_a, z_a, o_pre, i_pre, f_pre, conv_w, conv_b, w_q, w_k, w_v, b_i, b_f, head_g, skip):
    Bsz, L, _ = u_a.shape
    H, dh = MLSTM_HEADS, MLSTM_HEAD_DIM
    c = jax.nn.silu(causal_dwconv(u_a, conv_w, conv_b))
    ch = c.reshape(Bsz, L, H, dh)
    uh = u_a.reshape(Bsz, L, H, dh)
    q = jnp.einsum('blhd,hde->bhle', ch, w_q).astype(jnp.float32)
    k = jnp.einsum('blhd,hde->bhle', ch, w_k).astype(jnp.float32)
    v = jnp.einsum('blhd,hde->bhle', uh, w_v).astype(jnp.float32)
    ig = jnp.transpose(i_pre.astype(jnp.float32) + b_i.astype(jnp.float32), (0, 2, 1))
    lf = jax.nn.log_sigmoid(jnp.transpose(f_pre.astype(jnp.float32) + b_f.astype(jnp.float32), (0, 2, 1)))
    h = mlstm_chunkwise(q, k, v, ig, lf)
    o = jnp.transpose(jax.nn.sigmoid(o_pre.astype(jnp.float32)).reshape(Bsz, L, H, dh), (0, 2, 1, 3))
    h = o * h
    h = h * lax.rsqrt(jnp.mean(h * h, axis=-1, keepdims=True) + NORM_EPS)
    h = jnp.transpose(h, (0, 2, 1, 3)).reshape(Bsz, L, MLSTM_WIDTH) * head_g.astype(jnp.float32)
    h = h.astype(u_a.dtype) + skip * c
    return h * jax.nn.silu(z_a)


def s5_branch(u_b, z_b, lam_re, lam_im, log_dt, B_re, B_im, C_re, C_im, D_skip, w_glu, b_glu):
    Bsz, L, _ = u_b.shape
    u = u_b.astype(jnp.float32).reshape(Bsz, L, S5_GROUPS, S5_GROUP)
    dt = jnp.exp(log_dt.astype(jnp.float32))[:, None]
    lr = lam_re.astype(jnp.float32)
    li = lam_im.astype(jnp.float32)
    mag = jnp.exp(lr * dt)
    a_re = mag * jnp.cos(li * dt)
    a_im = mag * jnp.sin(li * dt)
    den = lr * lr + li * li
    nr = a_re - 1.0
    q_re = (nr * lr + a_im * li) / den
    q_im = (a_im * lr - nr * li) / den
    Br = B_re.astype(jnp.float32)
    Bi = B_im.astype(jnp.float32)
    bb_re = q_re[..., None] * Br - q_im[..., None] * Bi
    bb_im = q_re[..., None] * Bi + q_im[..., None] * Br
    bu_re = jnp.einsum('blgn,gpn->blgp', u, bb_re)
    bu_im = jnp.einsum('blgn,gpn->blgp', u, bb_im)
    a_re_b = jnp.broadcast_to(a_re, bu_re.shape)
    a_im_b = jnp.broadcast_to(a_im, bu_re.shape)

    def combine(e1, e2):
        a1r, a1i, b1r, b1i = e1
        a2r, a2i, b2r, b2i = e2
        return (a2r * a1r - a2i * a1i, a2r * a1i + a2i * a1r,
                a2r * b1r - a2i * b1i + b2r, a2r * b1i + a2i * b1r + b2i)

    _, _, s_re, s_im = lax.associative_scan(combine, (a_re_b, a_im_b, bu_re, bu_im), axis=1)
    y = (jnp.einsum('blgp,gnp->blgn', s_re, C_re.astype(jnp.float32))
         - jnp.einsum('blgp,gnp->blgn', s_im, C_im.astype(jnp.float32))
         + D_skip.astype(jnp.float32) * u)
    y = jax.nn.gelu(y.reshape(Bsz, L, S5_WIDTH)).astype(u_b.dtype)
    y = y * jax.nn.sigmoid(y @ w_glu + b_glu)
    return y * jax.nn.silu(z_b)


def setup_inputs(seed: int = 0) -> dict:
    key = jax.random.key(seed)
    ks = jax.random.split(key, 32)
    f32 = jnp.float32
    nrm = lambda k, shape, scale: scale * jax.random.normal(k, shape, f32)
    H, dh, P, G, N = MLSTM_HEADS, MLSTM_HEAD_DIM, S5_STATE, S5_GROUPS, S5_GROUP
    x = jax.random.normal(ks[0], (BATCH, SEQ, D_MODEL), f32)
    norm_pre_g = 1.0 + nrm(ks[1], (DEPTH, D_MODEL), 0.02)
    w_in = nrm(ks[2], (DEPTH, D_MODEL, IN_TOTAL), D_MODEL ** -0.5)
    conv_w = nrm(ks[3], (DEPTH, CONV_WIDTH, MLSTM_WIDTH), CONV_WIDTH ** -0.5)
    conv_b = nrm(ks[4], (DEPTH, MLSTM_WIDTH), 0.01)
    w_q = nrm(ks[5], (DEPTH, H, dh, dh), dh ** -0.5)
    w_k = nrm(ks[6], (DEPTH, H, dh, dh), dh ** -0.5)
    w_v = nrm(ks[7], (DEPTH, H, dh, dh), dh ** -0.5)
    b_i = nrm(ks[8], (DEPTH, H), 0.1)
    b_f = 3.0 + 3.0 * jax.random.uniform(ks[9], (DEPTH, H), f32)
    head_g = 1.0 + nrm(ks[10], (DEPTH, MLSTM_WIDTH), 0.02)
    skip_a = 1.0 + nrm(ks[11], (DEPTH, MLSTM_WIDTH), 0.02)
    w_a_out = nrm(ks[12], (DEPTH, MLSTM_WIDTH, D_MODEL), MLSTM_WIDTH ** -0.5)
    lam_re = -0.5 + nrm(ks[13], (DEPTH, G, P), 0.01)
    lam_im = math.pi * jnp.arange(P, dtype=f32)[None, None, :] + nrm(ks[14], (DEPTH, G, P), 0.01)
    log_dt = math.log(DT_MIN) + (math.log(DT_MAX) - math.log(DT_MIN)) * jax.random.uniform(ks[15], (DEPTH, G), f32)
    B_re = nrm(ks[16], (DEPTH, G, P, N), (2.0 * N) ** -0.5)
    B_im = nrm(ks[17], (DEPTH, G, P, N), (2.0 * N) ** -0.5)
    C_re = nrm(ks[18], (DEPTH, G, N, P), P ** -0.5)
    C_im = nrm(ks[19], (DEPTH, G, N, P), P ** -0.5)
    D_skip = nrm(ks[20], (DEPTH, G, N), 1.0)
    w_glu = nrm(ks[21], (DEPTH, S5_WIDTH, S5_WIDTH), S5_WIDTH ** -0.5)
    b_glu = nrm(ks[22], (DEPTH, S5_WIDTH), 0.01)
    w_b_out = nrm(ks[23], (DEPTH, S5_WIDTH, D_MODEL), S5_WIDTH ** -0.5)
    w_o = nrm(ks[24], (DEPTH, D_MODEL, D_MODEL), D_MODEL ** -0.5)
    norm_post_g = 1.0 + nrm(ks[25], (DEPTH, D_MODEL), 0.02)
    return {"x": x, "norm_pre_g": norm_pre_g, "w_in": w_in, "conv_w": conv_w, "conv_b": conv_b,
            "w_q": w_q, "w_k": w_k, "w_v": w_v, "b_i": b_i, "b_f": b_f, "head_g": head_g,
            "skip_a": skip_a, "w_a_out": w_a_out, "lam_re": lam_re, "lam_im": lam_im,
            "log_dt": log_dt, "B_re": B_re, "B_im": B_im, "C_re": C_re, "C_im": C_im,
            "D_skip": D_skip, "w_glu": w_glu, "b_glu": b_glu, "w_b_out": w_b_out,
            "w_o": w_o, "norm_post_g": norm_post_g}


def reference(x, norm_pre_g, w_in, conv_w, conv_b, w_q, w_k, w_v, b_i, b_f, head_g, skip_a,
              w_a_out, lam_re, lam_im, log_dt, B_re, B_im, C_re, C_im, D_skip, w_glu, b_glu,
              w_b_out, w_o, norm_post_g):
    h = x
    split_points = _split_points()
    for l in range(DEPTH):
        xn = rmsnorm(h, norm_pre_g[l])
        proj = xn @ w_in[l]
        u_a, z_a, o_a, i_a, f_a, u_b, z_b, g_pre = jnp.split(proj, split_points, axis=-1)
        y_a = mlstm_branch(u_a, z_a, o_a, i_a, f_a, conv_w[l], conv_b[l], w_q[l], w_k[l], w_v[l],
                           b_i[l], b_f[l], head_g[l], skip_a[l]) @ w_a_out[l]
        y_b = s5_branch(u_b, z_b, lam_re[l], lam_im[l], log_dt[l], B_re[l], B_im[l], C_re[l],
                        C_im[l], D_skip[l], w_glu[l], b_glu[l]) @ w_b_out[l]
        g = jax.nn.sigmoid(g_pre.astype(jnp.float32)).astype(h.dtype)
        merged = g[..., :D_MODEL] * y_a + g[..., D_MODEL:] * y_b
        h = h + rmsnorm(merged @ w_o[l], norm_post_g[l])
    return h
```

```cpp
#include <hip/hip_runtime.h>
#include <hip/hip_cooperative_groups.h>
#include <cstdio>
#include <cstdint>
namespace cg = cooperative_groups;

typedef __attribute__((ext_vector_type(8))) short bf16x8;
typedef __attribute__((ext_vector_type(4))) float f32x4;
typedef unsigned short u16;
#define DUP 0
#ifndef PH_MASK
#define PH_MASK 0xFFFF
#endif

#define DEVI __device__ __forceinline__

constexpr int LSEQ = 8192, NTOK = 32768;
constexpr size_t MIB = 1ull << 20;
constexpr size_t O_XN = 0, O_UA = 64 * MIB, O_UB = 128 * MIB, O_CC = 160 * MIB, O_QM = 224 * MIB, O_KM = 288 * MIB,
                 O_KTS = 352 * MIB, O_VT = 416 * MIB, O_MISC = 480 * MIB;
constexpr size_t O_WINT = O_MISC, O_WQT = O_MISC + 12 * MIB, O_WKT = O_WQT + MIB / 2, O_WVT = O_WKT + MIB / 2,
                 O_WAT = O_WVT + MIB / 2, O_WBT = O_WAT + 2 * MIB, O_WGT = O_WBT + MIB, O_WOT = O_WGT + MIB / 2,
                 O_KMAT = O_WOT + 2 * MIB, O_GATES = O_KMAT + MIB, O_ALPHA = O_GATES + MIB, O_RS = O_ALPHA + MIB / 2,
                 O_INTER = O_RS + MIB / 2, O_EMT = O_INTER + MIB / 2, O_KSC = O_EMT + MIB / 2, O_RDEN = O_KSC + MIB / 2,
                 O_NLP = O_RDEN + MIB / 2, O_NPREV = O_NLP + 2 * MIB, O_ACH = O_NPREV + MIB, O_GML = O_ACH + MIB / 16, O_GBL = O_ACH + MIB / 8, O_BAR = O_ACH + MIB / 4, O_END = O_BAR + MIB / 4;
constexpr size_t O_YS5 = O_UA, O_PMAT = O_UA + 32 * MIB, O_CA = O_UA + 32 * MIB, O_XPREV = O_UA + 40 * MIB,
                 O_HSQP = O_UA, O_RSQP = O_UA + 4 * MIB, O_R16 = O_QM,  O_YBIN = O_UB, O_MERGED = O_CC, O_SG = O_QM, O_HBUF = O_KTS;
constexpr size_t OO_WE = 0, OO_E = 8 * MIB;

struct P {
  const float *x, *norm_pre_g, *w_in, *conv_w, *conv_b, *w_q, *w_k, *w_v, *b_i, *b_f, *head_g, *skip_a, *w_a_out,
      *lam_re, *lam_im, *log_dt, *B_re, *B_im, *C_re, *C_im, *D_skip, *w_glu, *b_glu, *w_b_out, *w_o, *norm_post_g;
  float* out;
  char* ws;
};

DEVI int tidx() { int t = threadIdx.x & 255; asm volatile("" : "+v"(t)); return t; }
DEVI int tidx512() { int t = threadIdx.x; asm volatile("" : "+v"(t)); return t; }
typedef __attribute__((ext_vector_type(2))) __bf16 bf16x2_t;
typedef __attribute__((ext_vector_type(2))) float f32x2_t;
DEVI unsigned pk2(float a, float b) {
  f32x2_t f = {a, b};
  return __builtin_bit_cast(unsigned, __builtin_convertvector(f, bf16x2_t));
}
DEVI u16 f2bf(float f) { return (u16)(pk2(f, 0.f) & 0xffffu); }
DEVI float bf2f(u16 h) { return __uint_as_float(((unsigned)h) << 16); }
DEVI uint2 pk4(f32x4 v) { return make_uint2(pk2(v[0], v[1]), pk2(v[2], v[3])); }
DEVI f32x4 unpk4(uint2 u) {
  f32x4 o; o[0] = __uint_as_float(u.x << 16); o[1] = __uint_as_float(u.x & 0xffff0000u);
  o[2] = __uint_as_float(u.y << 16); o[3] = __uint_as_float(u.y & 0xffff0000u); return o;
}
DEVI size_t kb32(size_t m, int k, int K) { return ((m >> 8) * (size_t)(K >> 5) + (k >> 5)) * 8192 + (m & 255) * 32 + (k & 31); }
DEVI void st_nt8(void* ptr, uint2 v) { __builtin_nontemporal_store((unsigned long long)v.x | ((unsigned long long)v.y << 32), (unsigned long long*)ptr); }
DEVI float sigm(float x) { return __builtin_amdgcn_rcpf(1.f + __expf(-x)); }
DEVI float siluf(float x) { return x * sigm(x); }
DEVI float geluf(float x) { float t = 0.7978845608028654f * (x + 0.044715f * x * x * x); return 0.5f * x * (1.f + tanhf(t)); }


#define XB_TMO      128
#define XB_XCNT(j)  (256  + 64 * (j))
#define XB_XSUB(j)  (1280 + 64 * (j))
#define XB_XGEN(j)  (2304 + 64 * (j))
#define XB_TOP      3328
#define XB_TOPGEN   3392
#define XCD_BAR_WORDS 3456
#define XB_SPIN_CAP (1u << 20)
#define LAS __attribute__((address_space(3)))
DEVI unsigned xb_ld(unsigned* p) { return __hip_atomic_load(p, __ATOMIC_RELAXED, __HIP_MEMORY_SCOPE_AGENT); }
DEVI unsigned xb_add(unsigned* p, unsigned v) { return __hip_atomic_fetch_add(p, v, __ATOMIC_RELAXED, __HIP_MEMORY_SCOPE_AGENT); }
DEVI unsigned xb_xcc_id() { return (unsigned)__builtin_amdgcn_s_getreg((3 << 11) | 20) & 0xFu; }
#define XB_SPIN(cond, bar) do { unsigned _sp = 0; while (cond) { __builtin_amdgcn_s_sleep(1); \
    if ((++_sp & 255u) == 0u) { if (xb_ld(&(bar)[XB_TMO])) break; if (_sp > XB_SPIN_CAP) { atomicAdd(&(bar)[XB_TMO], 1u); break; } } } } while (0)
struct XcdBarrier { unsigned* bar; unsigned x; volatile LAS unsigned* st; };
DEVI XcdBarrier xcd_barrier_post(unsigned* bar, volatile LAS unsigned* st) {
  XcdBarrier b; b.bar = bar; b.x = xb_xcc_id(); b.st = st;
  if (threadIdx.x == 0) (void)xb_add(&bar[XB_XCNT(b.x)], 1u);
  return b;
}
DEVI void xcd_barrier_complete(unsigned* bar, unsigned x, unsigned& nloc, unsigned& nx) {
  const unsigned G = gridDim.x * gridDim.y * gridDim.z;
  unsigned sum, cnt, mine, sp = 0u;
  for (;;) {
    sum = 0u; cnt = 0u; mine = 0u;
#pragma unroll
    for (unsigned j = 0; j < 16; ++j) { const unsigned c = xb_ld(&bar[XB_XCNT(j)]); sum += c; cnt += (c > 0u) ? 1u : 0u; mine = (j == x) ? c : mine; }
    if (sum == G) break;
    __builtin_amdgcn_s_sleep(1);
    if ((++sp & 255u) == 0u) { if (xb_ld(&bar[XB_TMO])) break; if (sp > XB_SPIN_CAP) { atomicAdd(&bar[XB_TMO], 1u); break; } }
  }
  nloc = mine > 0u ? mine : 1u; nx = cnt > 0u ? cnt : 1u;
}
DEVI void xcd_barrier(const XcdBarrier& b) {
  asm volatile("s_waitcnt vmcnt(0)" ::: "memory");
  __syncthreads();
  if (threadIdx.x == 0) {
    unsigned* bar = b.bar;
    __builtin_amdgcn_s_waitcnt(0);
    unsigned nloc = b.st[0], nx = b.st[1];
    if (nloc == 0u) { xcd_barrier_complete(bar, b.x, nloc, nx); b.st[0] = nloc; b.st[1] = nx; }
    const unsigned old = xb_add(&bar[XB_XSUB(b.x)], 1u);
    const unsigned gen = old / nloc;
    if (old + 1u == (gen + 1u) * nloc) {
      __builtin_amdgcn_fence(__ATOMIC_RELEASE, "agent");
      asm volatile("s_waitcnt vmcnt(0)" ::: "memory");
      const unsigned og = xb_add(&bar[XB_TOP], 1u);
      const unsigned tg = og / nx;
      if (og + 1u == (tg + 1u) * nx) xb_add(&bar[XB_TOPGEN], 1u);
      else XB_SPIN(xb_ld(&bar[XB_TOPGEN]) == tg, bar);
      __builtin_amdgcn_fence(__ATOMIC_ACQUIRE, "agent");
      xb_add(&bar[XB_XGEN(b.x)], 1u);
      asm volatile("s_waitcnt vmcnt(0)" ::: "memory");
    } else {
      XB_SPIN(xb_ld(&bar[XB_XGEN(b.x)]) == gen, bar);
      __builtin_amdgcn_fence(__ATOMIC_ACQUIRE, "agent");
      asm volatile("s_waitcnt vmcnt(0)" ::: "memory");
    }
  }
  __syncthreads();
}

DEVI void glds16(const void* g, char* l) {
  unsigned la = (unsigned)(unsigned long long)(LAS char*)l;
  unsigned base = __builtin_amdgcn_readfirstlane(la);
  asm volatile("s_mov_b32 m0, %0\n\ts_nop 0\n\tglobal_load_lds_dwordx4 %1, off" ::"s"(base), "v"(g) : "memory", "m0");
}
template <bool SWAP, class AL, class BL>
DEVI void gemm_acc(f32x4 (&acc)[4][4], char* lds, AL al, BL bl, int nk64) {
  const int nk = nk64 * 2;
  const int tid = tidx(), lane = tid & 63, wid = tid >> 6, wr = wid >> 1, wc = wid & 1, fr = lane & 15, fq = lane >> 4;
  const int sb = (tid & 63) * 16;
  const int swz = sb ^ (((sb >> 9) & 1) << 5);
  const int R0 = (tid >> 6) * 16 + (swz >> 6);
  const int C0 = (swz & 63) >> 1;
  const int lo = ((fr * 64 + fq * 16) ^ ((fr >> 3) << 5));
  const int wofs = tid * 16;
  asm volatile("s_waitcnt vmcnt(0)" ::: "memory");
  __syncthreads();
#pragma unroll
  for (int s0 = 0; s0 < 3; ++s0) {
    if (s0 < nk) {
      char* st = lds + s0 * 16384;
      const int kc = s0 * 32 + C0;
      glds16(al(R0, kc), st + wofs); glds16(al(R0 + 64, kc), st + wofs + 4096);
      glds16(bl(R0, kc), st + 8192 + wofs); glds16(bl(R0 + 64, kc), st + 8192 + wofs + 4096);
    }
  }
#pragma unroll 1
  for (int ks = 0; ks < nk; ++ks) {
    if (ks + 2 < nk) asm volatile("s_waitcnt vmcnt(8)" ::: "memory");
    else if (ks + 1 < nk) asm volatile("s_waitcnt vmcnt(4)" ::: "memory");
    else asm volatile("s_waitcnt vmcnt(0)" ::: "memory");
    __syncthreads();
    if (ks + 3 < nk) {
      char* st = lds + ((ks + 3) & 3) * 16384;
      const int kc = (ks + 3) * 32 + C0;
      glds16(al(R0, kc), st + wofs); glds16(al(R0 + 64, kc), st + wofs + 4096);
      glds16(bl(R0, kc), st + 8192 + wofs); glds16(bl(R0 + 64, kc), st + 8192 + wofs + 4096);
    }
    __builtin_amdgcn_sched_barrier(0);
    const char* cur = lds + (ks & 3) * 16384;
    bf16x8 af[4], bfr[4];
#pragma unroll
    for (int mi = 0; mi < 4; ++mi) af[mi] = *(const bf16x8*)(cur + (wr * 4 + mi) * 1024 + lo);
#pragma unroll
    for (int ni = 0; ni < 4; ++ni) bfr[ni] = *(const bf16x8*)(cur + 8192 + (wc * 4 + ni) * 1024 + lo);
#pragma unroll
    for (int mi = 0; mi < 4; ++mi)
#pragma unroll
      for (int ni = 0; ni < 4; ++ni) {
        if (SWAP) acc[mi][ni] = __builtin_amdgcn_mfma_f32_16x16x32_bf16(bfr[ni], af[mi], acc[mi][ni], 0, 0, 0);
        else acc[mi][ni] = __builtin_amdgcn_mfma_f32_16x16x32_bf16(af[mi], bfr[ni], acc[mi][ni], 0, 0, 0);
      }
  }
  __syncthreads();
}
template <bool SWAP>
DEVI void gemm_plain(f32x4 (&acc)[4][4], char* lds, const u16* A, size_t lda, const u16* B, size_t ldb, int nk) {
  gemm_acc<SWAP>(acc, lds, [=](int r, int k) { return (const void*)(A + (size_t)r * lda + k); },
                 [=](int n, int k) { return (const void*)(B + (size_t)n * ldb + k); }, nk);
}
DEVI void zero_acc(f32x4 (&acc)[4][4]) {
#pragma unroll
  for (int i = 0; i < 4; ++i)
#pragma unroll
    for (int j = 0; j < 4; ++j) acc[i][j] = f32x4{0.f, 0.f, 0.f, 0.f};
}
template <bool SWAP, class F>
DEVI void for_acc(f32x4 (&acc)[4][4], F f) {
  const int tid = tidx(), lane = tid & 63, wid = tid >> 6, wr = wid >> 1, wc = wid & 1, fr = lane & 15, fq = lane >> 4;
#pragma unroll
  for (int mi = 0; mi < 4; ++mi)
#pragma unroll
    for (int ni = 0; ni < 4; ++ni) {
      int r, c;
      if (SWAP) { r = wr * 64 + mi * 16 + fr; c = wc * 64 + ni * 16 + fq * 4; }
      else { r = wr * 64 + mi * 16 + fq * 4; c = wc * 64 + ni * 16 + fr; }
      f(mi, ni, r, c, acc[mi][ni]);
      __builtin_amdgcn_sched_barrier(0);
    }
}
template <bool SWAP, class F>
DEVI void for_idx(F f) {
  const int tid = tidx(), lane = tid & 63, wid = tid >> 6, wr = wid >> 1, wc = wid & 1, fr = lane & 15, fq = lane >> 4;
#pragma unroll
  for (int mi = 0; mi < 4; ++mi)
#pragma unroll
    for (int ni = 0; ni < 4; ++ni) {
      int r, c;
      if (SWAP) { r = wr * 64 + mi * 16 + fr; c = wc * 64 + ni * 16 + fq * 4; }
      else { r = wr * 64 + mi * 16 + fq * 4; c = wc * 64 + ni * 16 + fr; }
      f(mi, ni, r, c);
    }
}
DEVI float red_fq(float v) { v += __shfl_xor(v, 16); v += __shfl_xor(v, 32); return v; }


DEVI void wait_vm_stage(int rem) {
  if (rem >= 2) asm volatile("s_waitcnt vmcnt(8)" ::: "memory");
  else if (rem == 1) asm volatile("s_waitcnt vmcnt(4)" ::: "memory");
  else asm volatile("s_waitcnt vmcnt(0)" ::: "memory");
}
template <class AL, class BL>
DEVI void gemm8_acc(f32x4 (&acc)[8][4], char* lds, AL al, BL bl, int nk) {
  const int tid = tidx512(), lane = tid & 63, wid = tid >> 6, wr = wid >> 2, wc = wid & 3, fr = lane & 15, fq = lane >> 4;
  const int grp = __builtin_amdgcn_readfirstlane(wid >> 2);
  const int sb = (tid & 63) * 16;
  const int swz = sb ^ (((sb >> 9) & 1) << 5);
  const int R0 = (tid >> 6) * 16 + (swz >> 6);
  const int C0 = (swz & 63) >> 1;
  const int lo = ((fr * 64 + fq * 16) ^ ((fr >> 3) << 5));
  const int wofs = tid * 16;
  asm volatile("s_waitcnt vmcnt(0)" ::: "memory");
  __syncthreads();
#pragma unroll
  for (int s0 = 0; s0 < 3; ++s0) {
    if (s0 < nk) {
      char* st = lds + s0 * 32768;
      const int kc = s0 * 32 + C0;
      glds16(al(R0, kc), st + wofs); glds16(al(R0 + 128, kc), st + wofs + 8192);
      glds16(bl(R0, kc), st + 16384 + wofs); glds16(bl(R0 + 128, kc), st + 16384 + wofs + 8192);
    }
  }
  wait_vm_stage(nk - 1);
  __builtin_amdgcn_s_barrier();
  if (grp == 1) __builtin_amdgcn_s_barrier();
#pragma unroll 1
  for (int ks = 0; ks < nk; ++ks) {
    if (ks + 3 < nk) {
      char* st = lds + ((ks + 3) & 3) * 32768;
      const int kc = (ks + 3) * 32 + C0;
      glds16(al(R0, kc), st + wofs); glds16(al(R0 + 128, kc), st + wofs + 8192);
      glds16(bl(R0, kc), st + 16384 + wofs); glds16(bl(R0 + 128, kc), st + 16384 + wofs + 8192);
    }
    __builtin_amdgcn_sched_barrier(0);
    const char* cur = lds + (ks & 3) * 32768;
    bf16x8 af[8], bfr[4];
#pragma unroll
    for (int mi = 0; mi < 8; ++mi) af[mi] = *(const bf16x8*)(cur + (wr * 8 + mi) * 1024 + lo);
#pragma unroll
    for (int ni = 0; ni < 4; ++ni) bfr[ni] = *(const bf16x8*)(cur + 16384 + (wc * 4 + ni) * 1024 + lo);
    asm volatile("s_waitcnt lgkmcnt(0)" ::: "memory");
    if (grp == 1) wait_vm_stage(nk - 2 - ks);
    __builtin_amdgcn_sched_barrier(0);
    __builtin_amdgcn_s_barrier();
    __builtin_amdgcn_sched_barrier(0);
    __builtin_amdgcn_s_setprio(1);
#pragma unroll
    for (int mi = 0; mi < 8; ++mi)
#pragma unroll
      for (int ni = 0; ni < 4; ++ni) acc[mi][ni] = __builtin_amdgcn_mfma_f32_16x16x32_bf16(bfr[ni], af[mi], acc[mi][ni], 0, 0, 0);
    __builtin_amdgcn_s_setprio(0);
    if (grp == 0) wait_vm_stage(nk - 2 - ks);
    __builtin_amdgcn_sched_barrier(0);
    __builtin_amdgcn_s_barrier();
    __builtin_amdgcn_sched_barrier(0);
  }
  if (grp == 0) __builtin_amdgcn_s_barrier();
  __syncthreads();
}
DEVI void gemm8_plain(f32x4 (&acc)[8][4], char* lds, const u16* A, size_t lda, const u16* B, size_t ldb, int nk) {
  gemm8_acc(acc, lds, [=](int r, int k) { return (const void*)(A + (size_t)r * lda + k); },
            [=](int n, int k) { return (const void*)(B + (size_t)n * ldb + k); }, nk);
}
DEVI void glds16s(const u16* sbase, unsigned voff, char* l) {
  unsigned la = (unsigned)(unsigned long long)(LAS char*)l;
  unsigned base = __builtin_amdgcn_readfirstlane(la);
  asm volatile("s_mov_b32 m0, %0\n\ts_nop 0\n\tglobal_load_lds_dwordx4 %1, %2" ::"s"(base), "v"(voff), "s"(sbase) : "memory", "m0");
}
DEVI void gemm8_kb(f32x4 (&acc)[8][4], char* lds, const u16* At, const u16* Bt, int nk) {
  const int tid = tidx512(), lane = tid & 63, wid = tid >> 6, wr = wid >> 2, wc = wid & 3, fr = lane & 15, fq = lane >> 4;
  const int grp = __builtin_amdgcn_readfirstlane(wid >> 2);
  const int sb = (tid & 63) * 16;
  const int swz = sb ^ (((sb >> 9) & 1) << 5);
  const unsigned voff = (unsigned)((tid >> 6) * 1024 + swz);
  const int lo = ((fr * 64 + fq * 16) ^ ((fr >> 3) << 5));
  const int wofs = tid * 16;
  asm volatile("s_waitcnt vmcnt(0)" ::: "memory");
  __syncthreads();
#pragma unroll
  for (int s0 = 0; s0 < 3; ++s0) {
    if (s0 < nk) {
      char* st = lds + s0 * 32768;
      glds16s(At + (size_t)s0 * 8192, voff, st + wofs); glds16s(At + (size_t)s0 * 8192 + 4096, voff, st + wofs + 8192);
      glds16s(Bt + (size_t)s0 * 8192, voff, st + 16384 + wofs); glds16s(Bt + (size_t)s0 * 8192 + 4096, voff, st + 16384 + wofs + 8192);
    }
  }
  wait_vm_stage(nk - 1);
  __builtin_amdgcn_s_barrier();
  if (grp == 1) __builtin_amdgcn_s_barrier();
#pragma unroll 1
  for (int ks = 0; ks < nk; ++ks) {
    const char* cur = lds + (ks & 3) * 32768;
    bf16x8 af[8], bfr[4];
#pragma unroll
    for (int mi = 0; mi < 8; ++mi) af[mi] = *(const bf16x8*)(cur + (wr * 8 + mi) * 1024 + lo);
#pragma unroll
    for (int ni = 0; ni < 4; ++ni) bfr[ni] = *(const bf16x8*)(cur + 16384 + (wc * 4 + ni) * 1024 + lo);
    __builtin_amdgcn_sched_barrier(0);
    if (ks + 3 < nk) {
      char* st = lds + ((ks + 3) & 3) * 32768;
      const u16* as = At + (size_t)(ks + 3) * 8192;
      const u16* bs = Bt + (size_t)(ks + 3) * 8192;
      glds16s(as, voff, st + wofs); glds16s(as + 4096, voff, st + wofs + 8192);
      glds16s(bs, voff, st + 16384 + wofs); glds16s(bs + 4096, voff, st + 16384 + wofs + 8192);
    }
    asm volatile("s_waitcnt lgkmcnt(0)" ::: "memory");
    if (grp == 1) wait_vm_stage(nk - 2 - ks);
    __builtin_amdgcn_sched_barrier(0);
    __builtin_amdgcn_s_barrier();
    __builtin_amdgcn_sched_barrier(0);
    __builtin_amdgcn_s_setprio(1);
#pragma unroll
    for (int mi = 0; mi < 8; ++mi)
#pragma unroll
      for (int ni = 0; ni < 4; ++ni) acc[mi][ni] = __builtin_amdgcn_mfma_f32_16x16x32_bf16(bfr[ni], af[mi], acc[mi][ni], 0, 0, 0);
    __builtin_amdgcn_s_setprio(0);
    if (grp == 0) wait_vm_stage(nk - 2 - ks);
    __builtin_amdgcn_sched_barrier(0);
    __builtin_amdgcn_s_barrier();
    __builtin_amdgcn_sched_barrier(0);
  }
  if (grp == 0) __builtin_amdgcn_s_barrier();
  __syncthreads();
}
DEVI void zero_acc8(f32x4 (&acc)[8][4]) {
#pragma unroll
  for (int i = 0; i < 8; ++i)
#pragma unroll
    for (int j = 0; j < 4; ++j) acc[i][j] = f32x4{0.f, 0.f, 0.f, 0.f};
}
template <int MH = 4, bool SB = true, class PRE, class MAIN>
DEVI void epi8(f32x4 (&acc)[8][4], PRE pre, MAIN mainf) {
  const int tid = tidx512(), lane = tid & 63, wid = tid >> 6, wr = wid >> 2, wc = wid & 3, fr = lane & 15, fq = lane >> 4;
#pragma unroll
  for (int h = 0; h < 8 / MH; ++h) {
#pragma unroll
    for (int m = 0; m < MH; ++m)
#pragma unroll
      for (int ni = 0; ni < 4; ++ni) pre(m, ni, wr * 128 + (h * MH + m) * 16 + fr, wc * 64 + ni * 16 + fq * 4);
    if (SB) __builtin_amdgcn_sched_barrier(0);
#pragma unroll
    for (int m = 0; m < MH; ++m)
#pragma unroll
      for (int ni = 0; ni < 4; ++ni) {
        mainf(m, h * MH + m, ni, wr * 128 + (h * MH + m) * 16 + fr, wc * 64 + ni * 16 + fq * 4, acc[h * MH + m][ni]);
        if (SB) __builtin_amdgcn_sched_barrier(0);
      }
  }
}

struct S5gp { float lrdt, lidt, qre, qim; };
DEVI void sincos_rr(float ang, float& s, float& c) {
  float k = rintf(ang * 0.15915494309189535f);
  float r = fmaf(-k, 6.2831855f, ang);
  r = fmaf(-k, -1.7484556e-7f, r);
  s = __sinf(r); c = __cosf(r);
}
DEVI S5gp s5_gp(const P& p, int g, int pp) {
  float dt = expf(p.log_dt[g]);
  float lr = p.lam_re[g * 64 + pp], li = p.lam_im[g * 64 + pp];
  float mag = expf(lr * dt), s, c;
  sincos_rr(li * dt, s, c);
  float are = mag * c, aim = mag * s, den = lr * lr + li * li, nr = are - 1.f;
  S5gp r; r.qre = (nr * lr + aim * li) / den; r.qim = (aim * lr - nr * li) / den; r.lrdt = lr * dt; r.lidt = li * dt;
  return r;
}
DEVI void s5_pow(const S5gp& s, float n, float& er, float& ei) {
  float mag = expf(s.lrdt * n), sn, cs;
  sincos_rr(s.lidt * n, sn, cs);
  er = mag * cs; ei = mag * sn;
}

DEVI void transpose_tile(const float* src, size_t ld_src, int srccol0, int k0, u16* dst, size_t ld_dst, int n0, float* tile, bool kb = false) {
  const int tid = tidx(), tx = tid & 15, ty = tid >> 4;
  __syncthreads();
#pragma unroll
  for (int rr = 0; rr < 4; ++rr) {
    int k = ty + 16 * rr;
    float4 v = *(const float4*)(src + (size_t)(k0 + k) * ld_src + srccol0 + tx * 4);
    tile[k * 65 + tx * 4 + 0] = v.x; tile[k * 65 + tx * 4 + 1] = v.y; tile[k * 65 + tx * 4 + 2] = v.z; tile[k * 65 + tx * 4 + 3] = v.w;
  }
  __syncthreads();
  const int kx = tid & 7, ny = tid >> 3;
#pragma unroll
  for (int rr = 0; rr < 2; ++rr) {
    int n = ny + 32 * rr;
    float f[8];
#pragma unroll
    for (int e = 0; e < 8; ++e) f[e] = tile[(kx * 8 + e) * 65 + n];
    uint4 o = make_uint4(pk2(f[0], f[1]), pk2(f[2], f[3]), pk2(f[4], f[5]), pk2(f[6], f[7]));
    if (kb) *(uint4*)(dst + kb32(n0 + n, k0 + kx * 8, (int)ld_dst)) = o;
    else *(uint4*)(dst + (size_t)(n0 + n) * ld_dst + k0 + kx * 8) = o;
  }
}

constexpr int T0_WIN = 1536, T0_QKV = 192, T0_WA = 256, T0_WB = 128, T0_WG = 64, T0_WO = 256;
constexpr int T0_TR = T0_WIN + T0_QKV + T0_WA + T0_WB + T0_WG + T0_WO;
constexpr int T0_KMAT = 512, T0_WE = 512, T0_NORM = 2048;
constexpr int T0_ALL = T0_TR + T0_KMAT + T0_WE + T0_NORM;

DEVI void phase0(const P& p, char* lds, int t) {
  const int tid = tidx();
  char* ws = p.ws;
  if (t < T0_TR) {
    float* tile = (float*)lds;
    if (t < T0_WIN) {
      int kt = t / 96, nt = t % 96, n0 = nt * 64;
      transpose_tile(p.w_in, 6152, n0 + (n0 >= 3072 ? 8 : 0), kt * 64, (u16*)(ws + O_WINT), 1024, n0, tile, true);
      return;
    }
    t -= T0_WIN;
    if (t < T0_QKV) {
      int which = t / 64, r = t % 64, h = r / 16, kt = (r % 16) / 4, nt = r % 4;
      const float* src = (which == 0 ? p.w_q : which == 1 ? p.w_k : p.w_v) + (size_t)h * 65536;
      u16* dst = (u16*)(ws + (which == 0 ? O_WQT : which == 1 ? O_WKT : O_WVT)) + (size_t)h * 65536;
      transpose_tile(src, 256, nt * 64, kt * 64, dst, 256, nt * 64, tile);
      return;
    }
    t -= T0_QKV;
    if (t < T0_WA) { transpose_tile(p.w_a_out, 1024, (t % 16) * 64, (t / 16) * 64, (u16*)(ws + O_WAT), 1024, (t % 16) * 64, tile, true); return; }
    t -= T0_WA;
    if (t < T0_WB) { transpose_tile(p.w_b_out, 1024, (t % 16) * 64, (t / 16) * 64, (u16*)(ws + O_WBT), 512, (t % 16) * 64, tile, true); return; }
    t -= T0_WB;
    if (t < T0_WG) { transpose_tile(p.w_glu, 512, (t % 8) * 64, (t / 8) * 64, (u16*)(ws + O_WGT), 512, (t % 8) * 64, tile, true); return; }
    t -= T0_WG;
    transpose_tile(p.w_o, 1024, (t % 16) * 64, (t / 16) * 64, (u16*)(ws + O_WOT), 1024, (t % 16) * 64, tile, true);
    return;
  }
  t -= T0_TR;
  if (t < T0_KMAT) {
    const int g = t >> 4, lag0 = (t & 15) * 4;
    float* Wre = (float*)lds;
    float* Wim = Wre + 4 * 16 * 68;
    __syncthreads();
    {
      const int ll = tid >> 6, pp = tid & 63;
      S5gp sg5 = s5_gp(p, g, pp);
      float er, ei; s5_pow(sg5, (float)(lag0 + ll), er, ei);
      const float* Br = p.B_re + (size_t)(g * 64 + pp) * 16;
      const float* Bi = p.B_im + (size_t)(g * 64 + pp) * 16;
#pragma unroll
      for (int m = 0; m < 16; ++m) {
        float br = Br[m], bi = Bi[m];
        float bbr = sg5.qre * br - sg5.qim * bi, bbi = sg5.qre * bi + sg5.qim * br;
        Wre[(ll * 16 + m) * 68 + pp] = er * bbr - ei * bbi;
        Wim[(ll * 16 + m) * 68 + pp] = er * bbi + ei * bbr;
      }
    }
    __syncthreads();
    {
      const int ll = tid >> 6, n = (tid >> 2) & 15, mq = tid & 3;
      const float* cr = p.C_re + (size_t)(g * 16 + n) * 64;
      const float* ci = p.C_im + (size_t)(g * 16 + n) * 64;
      float acc[4] = {0.f, 0.f, 0.f, 0.f};
#pragma unroll 4
      for (int p4 = 0; p4 < 16; ++p4) {
        float4 c_r = *(const float4*)(cr + p4 * 4), c_i = *(const float4*)(ci + p4 * 4);
#pragma unroll
        for (int e = 0; e < 4; ++e) {
          float4 wr4 = *(const float4*)(Wre + (ll * 16 + mq * 4 + e) * 68 + p4 * 4);
          float4 wi4 = *(const float4*)(Wim + (ll * 16 + mq * 4 + e) * 68 + p4 * 4);
          acc[e] += c_r.x * wr4.x - c_i.x * wi4.x + c_r.y * wr4.y - c_i.y * wi4.y + c_r.z * wr4.z - c_i.z * wi4.z + c_r.w * wr4.w - c_i.w * wi4.w;
        }
      }
      *(uint2*)((u16*)(ws + O_KMAT) + ((size_t)(g * 64 + lag0 + ll) * 16 + n) * 16 + mq * 4) = make_uint2(pk2(acc[0], acc[1]), pk2(acc[2], acc[3]));
    }
    return;
  }
  t -= T0_KMAT;
  if (t < T0_WE) {
    int gid = t * 256 + tid, i = gid & 63, pp = (gid >> 6) & 63, g = gid >> 12;
    S5gp s = s5_gp(p, g, pp);
    float er, ei; s5_pow(s, (float)(63 - i), er, ei);
    const float* Br = p.B_re + (size_t)(g * 64 + pp) * 16;
    const float* Bi = p.B_im + (size_t)(g * 64 + pp) * 16;
    float vr[16], vi[16];
#pragma unroll
    for (int m = 0; m < 16; ++m) {
      float br = Br[m], bi = Bi[m];
      float bbr = s.qre * br - s.qim * bi, bbi = s.qre * bi + s.qim * br;
      vr[m] = er * bbr - ei * bbi; vi[m] = er * bbi + ei * bbr;
    }
    u16* we = (u16*)((char*)p.out + OO_WE);
    uint4* d0 = (uint4*)(we + (size_t)(g * 128 + pp) * 1024 + i * 16);
    uint4* d1 = (uint4*)(we + (size_t)(g * 128 + 64 + pp) * 1024 + i * 16);
    d0[0] = make_uint4(pk2(vr[0], vr[1]), pk2(vr[2], vr[3]), pk2(vr[4], vr[5]), pk2(vr[6], vr[7]));
    d0[1] = make_uint4(pk2(vr[8], vr[9]), pk2(vr[10], vr[11]), pk2(vr[12], vr[13]), pk2(vr[14], vr[15]));
    d1[0] = make_uint4(pk2(vi[0], vi[1]), pk2(vi[2], vi[3]), pk2(vi[4], vi[5]), pk2(vi[6], vi[7]));
    d1[1] = make_uint4(pk2(vi[8], vi[9]), pk2(vi[10], vi[11]), pk2(vi[12], vi[13]), pk2(vi[14], vi[15]));
    return;
  }
  t -= T0_WE;
  {
    const int lane = tid & 63;
    float4 vv[4][4];
#pragma unroll
    for (int q = 0; q < 4; ++q) {
      const float* xr = p.x + (size_t)(t * 16 + q * 4 + (tid >> 6)) * 1024;
#pragma unroll
      for (int j = 0; j < 4; ++j) { f32x4 tx = __builtin_nontemporal_load((const f32x4*)(xr + j * 256 + lane * 4)); vv[q][j] = make_float4(tx[0], tx[1], tx[2], tx[3]); }
    }
    float4 gg[4];
#pragma unroll
    for (int j = 0; j < 4; ++j) gg[j] = *(const float4*)(p.norm_pre_g + j * 256 + lane * 4);
    u16* xn = (u16*)(ws + O_XN);
#pragma unroll
    for (int q = 0; q < 4; ++q) {
      const int row = t * 16 + q * 4 + (tid >> 6);
      float ss = 0.f;
#pragma unroll
      for (int j = 0; j < 4; ++j) ss += vv[q][j].x * vv[q][j].x + vv[q][j].y * vv[q][j].y + vv[q][j].z * vv[q][j].z + vv[q][j].w * vv[q][j].w;
#pragma unroll
      for (int o = 32; o >= 1; o >>= 1) ss += __shfl_xor(ss, o);
      float rstd = rsqrtf(ss * (1.f / 1024.f) + 1e-6f);
      float gp[8];
#pragma unroll
      for (int qq = 0; qq < 8; ++qq) gp[qq] = 0.f;
#pragma unroll
      for (int j = 0; j < 4; ++j) {
        int k = j * 256 + lane * 4;
        float4 g = gg[j];
        float e[4] = {vv[q][j].x * rstd * g.x, vv[q][j].y * rstd * g.y, vv[q][j].z * rstd * g.z, vv[q][j].w * rstd * g.w};
        *(uint2*)(xn + kb32(row, k, 1024)) = make_uint2(pk2(e[0], e[1]), pk2(e[2], e[3]));
#pragma unroll
        for (int qq = 0; qq < 8; ++qq) {
          float4 w = *(const float4*)((const float*)lds + qq * 1024 + k);
          gp[qq] += e[0] * w.x + e[1] * w.y + e[2] * w.z + e[3] * w.w;
        }
      }
#pragma unroll
      for (int qq = 0; qq < 8; ++qq) {
#pragma unroll
        for (int o = 32; o >= 1; o >>= 1) gp[qq] += __shfl_xor(gp[qq], o);
      }
      if (lane == 0) {
        float* gt = (float*)(ws + O_GATES) + (size_t)row * 8;
        *(float4*)(gt) = make_float4(gp[0], gp[1], gp[2], gp[3]);
        *(float4*)(gt + 4) = make_float4(gp[4], gp[5], gp[6], gp[7]);
      }
    }
  }
}

DEVI void phase1(const P& p, char* lds, int t) {
  char* ws = p.ws;
  int mt = t / 12, nt = t % 12;
  const u16* A = (const u16*)(ws + O_XN) + (size_t)mt * 128 * 1024;
  int wrow = nt < 8 ? nt * 128 : 3072 + (nt - 8) * 128;
  const u16* B = (const u16*)(ws + O_WINT) + (size_t)wrow * 1024;
  f32x4 acc[4][4]; zero_acc(acc);
  gemm_plain<true>(acc, lds, A, 1024, B, 1024, 16);
  u16* dst; size_t ld;
  if (nt < 8) { dst = (u16*)(ws + O_UA) + (size_t)mt * 128 * 1024 + nt * 128; ld = 1024; }
  else { dst = (u16*)(ws + O_UB) + (size_t)mt * 128 * 512 + (nt - 8) * 128; ld = 512; }
  for_acc<true>(acc, [&](int, int, int r, int c, f32x4 v) { *(uint2*)(dst + (size_t)r * ld + c) = pk4(v); });
}

constexpr int T2_GATE = 256, T2_E = 128, T2_V = 2048, T2_CONV = 512, T2_ALL = T2_GATE + T2_E + T2_V + T2_CONV;
DEVI float wave_incl_sum(float v, int lane) {
#pragma unroll
  for (int o = 1; o < 64; o <<= 1) { float u = __shfl_up(v, o); if (lane >= o) v += u; }
  return v;
}
DEVI float wave_incl_max(float v, int lane) {
#pragma unroll
  for (int o = 1; o < 64; o <<= 1) { float u = __shfl_up(v, o); if (lane >= o) v = fmaxf(v, u); }
  return v;
}

DEVI void gate_pass1(const P& p, int t) {
  const int tid = tidx(), lane = tid & 63, wid = tid >> 6;
  char* ws = p.ws;
  const int bh = t >> 4, c = (t & 15) * 4 + wid, b = bh >> 2, h = bh & 3;
  const float* gates = (const float*)(ws + O_GATES);
  float* A_ = (float*)(ws + O_ALPHA) + (size_t)bh * LSEQ;
  float* R_ = (float*)(ws + O_RS) + (size_t)bh * LSEQ;
  float* I_ = (float*)(ws + O_INTER) + (size_t)bh * LSEQ;
  const float bi = p.b_i[h], bf = p.b_f[h];
  const float NINF = -__builtin_huge_valf();
  int tp = c * 128 + 2 * lane;
  size_t tok = (size_t)b * LSEQ + tp;
  float ig0 = gates[tok * 8 + h] + bi, ig1 = gates[(tok + 1) * 8 + h] + bi;
  float f0 = gates[tok * 8 + 4 + h] + bf, f1 = gates[(tok + 1) * 8 + 4 + h] + bf;
  float lf0 = fminf(f0, 0.f) - log1pf(expf(-fabsf(f0)));
  float lf1 = fminf(f1, 0.f) - log1pf(expf(-fabsf(f1)));
  float s1 = lf0 + lf1;
  float incl = wave_incl_sum(s1, lane);
  float excl = incl - s1;
  float b0 = excl + lf0, b1 = excl + s1;
  float blast = __shfl(incl, 63);
  float r0 = ig0 - b0, r1 = ig1 - b1;
  float pm = fmaxf(r0, r1);
  float im = wave_incl_max(pm, lane);
  float em = __shfl_up(im, 1); if (lane == 0) em = NINF;
  float rm0 = fmaxf(em, r0), rm1 = fmaxf(em, pm);
  float mall = __shfl(im, 63);
  *(float2*)(A_ + tp) = make_float2(b0, b1);
  *(float2*)(R_ + tp) = make_float2(r0, r1);
  *(float2*)(I_ + tp) = make_float2(rm0, rm1);
  if (lane == 0) { ((float*)(ws + O_GML))[bh * 64 + c] = blast + mall; ((float*)(ws + O_GBL))[bh * 64 + c] = blast; }
}

DEVI void phase2(const P& p, char* lds, int t) {
  const int tid = tidx(), lane = tid & 63, wid = tid >> 6;
  char* ws = p.ws;
  if (t < T2_GATE) {
    const int bh = t >> 4, c = (t & 15) * 4 + wid;
    const float* gml = (const float*)(ws + O_GML) + bh * 64;
    const float* gbl = (const float*)(ws + O_GBL) + bh * 64;
    float* A_ = (float*)(ws + O_ALPHA) + (size_t)bh * LSEQ;
    float* R_ = (float*)(ws + O_RS) + (size_t)bh * LSEQ;
    float* I_ = (float*)(ws + O_INTER) + (size_t)bh * LSEQ;
    float* E_ = (float*)(ws + O_EMT) + (size_t)bh * LSEQ;
    float* K_ = (float*)(ws + O_KSC) + (size_t)bh * LSEQ;
    const float NINF = -__builtin_huge_valf();
    float a = gbl[lane], bsc = gml[lane];
    float A = a, B = bsc;
#pragma unroll
    for (int o = 1; o < 64; o <<= 1) {
      float Ap = __shfl_up(A, o), Bp = __shfl_up(B, o);
      if (lane >= o) { B = fmaxf(Bp + A, B); A = Ap + A; }
    }
    float Bprev = __shfl_up(B, 1); if (lane == 0) Bprev = NINF;
    const float mp = __shfl(Bprev, c), mn = __shfl(B, c), bl = __shfl(a, c);
    if (lane == 0) ((float*)(ws + O_ACH))[bh * 64 + c] = (mp == NINF) ? 0.f : expf(bl + mp - mn);
    int tp = c * 128 + 2 * lane;
    float2 bb = *(float2*)(A_ + tp), rr = *(float2*)(R_ + tp), rm = *(float2*)(I_ + tp);
    float mt0 = bb.x + fmaxf(mp, rm.x), mt1 = bb.y + fmaxf(mp, rm.y);
    float a0 = bb.x - mt0, a1 = bb.y - mt1;
    float i0 = (mp == NINF) ? 0.f : expf(a0 + mp), i1 = (mp == NINF) ? 0.f : expf(a1 + mp);
    *(float2*)(A_ + tp) = make_float2(a0, a1);
    *(float2*)(I_ + tp) = make_float2(i0, i1);
    *(float2*)(E_ + tp) = make_float2(expf(-mt0), expf(-mt1));
    *(float2*)(K_ + tp) = make_float2(expf(bl + rr.x - mn), expf(bl + rr.y - mn));
    return;
  }
  t -= T2_GATE;
  if (t < T2_E) {
    int g = t >> 2, mt = t & 3;
    const u16* ub = (const u16*)(ws + O_UB) + (size_t)g * 524288 + (size_t)mt * 128 * 1024;
    const u16* we = (const u16*)((char*)p.out + OO_WE) + (size_t)g * 128 * 1024;
    f32x4 acc[4][4]; zero_acc(acc);
    gemm_plain<true>(acc, lds, ub, 1024, we, 1024, 16);
    float* E = (float*)((char*)p.out + OO_E);
    for_acc<true>(acc, [&](int, int, int r, int c, f32x4 v) {
      *(f32x4*)(E + ((size_t)(mt * 128 + r) * 32 + g) * 128 + c) = v;
    });
    return;
  }
  t -= T2_E;
  if (t < T2_V) {
    int mt = t >> 3, h = (t >> 1) & 3, nt = t & 1;
    const u16* A = (const u16*)(ws + O_UA) + (size_t)mt * 128 * 1024 + h * 256;
    const u16* B = (const u16*)(ws + O_WVT) + (size_t)(h * 256 + nt * 128) * 256;
    f32x4 acc[4][4]; zero_acc(acc);
    gemm_plain<false>(acc, lds, A, 1024, B, 256, 4);
    int bh = (mt >> 6) * 4 + h, tp0 = (mt & 63) * 128;
    u16* vt = (u16*)(ws + O_VT) + (size_t)(bh * 64 + (mt & 63)) * 32768 + (nt * 128) * 32;
    for_acc<false>(acc, [&](int, int, int r, int c, f32x4 v) { *(uint2*)(vt + (size_t)(r >> 5) * 8192 + c * 32 + (r & 31)) = pk4(v); });
    return;
  }
  t -= T2_V;
  {
    const int cg8 = (tid & 127) * 8, half = tid >> 7;
    const int tok0 = t * 64 + half * 32, tp0 = tok0 & (LSEQ - 1);
    float w[4][8], bias[8];
#pragma unroll
    for (int j = 0; j < 4; ++j) {
      float4 a = *(const float4*)(p.conv_w + j * 1024 + cg8), b = *(const float4*)(p.conv_w + j * 1024 + cg8 + 4);
      w[j][0] = a.x; w[j][1] = a.y; w[j][2] = a.z; w[j][3] = a.w; w[j][4] = b.x; w[j][5] = b.y; w[j][6] = b.z; w[j][7] = b.w;
    }
    {
      float4 a = *(const float4*)(p.conv_b + cg8), b = *(const float4*)(p.conv_b + cg8 + 4);
      bias[0] = a.x; bias[1] = a.y; bias[2] = a.z; bias[3] = a.w; bias[4] = b.x; bias[5] = b.y; bias[6] = b.z; bias[7] = b.w;
    }
    const u16* ua = (const u16*)(ws + O_UA);
    u16* cc = (u16*)(ws + O_CC);
    float h0[8], h1[8], h2[8];
    auto ld8 = [&](int tok, float* o) {
      uint4 u = *(const uint4*)(ua + (size_t)tok * 1024 + cg8);
      o[0] = __uint_as_float(u.x << 16); o[1] = __uint_as_float(u.x & 0xffff0000u);
      o[2] = __uint_as_float(u.y << 16); o[3] = __uint_as_float(u.y & 0xffff0000u);
      o[4] = __uint_as_float(u.z << 16); o[5] = __uint_as_float(u.z & 0xffff0000u);
      o[6] = __uint_as_float(u.w << 16); o[7] = __uint_as_float(u.w & 0xffff0000u);
    };
#pragma unroll
    for (int e = 0; e < 8; ++e) { h0[e] = 0.f; h1[e] = 0.f; h2[e] = 0.f; }
    if (tp0 >= 3) { ld8(tok0 - 3, h0); ld8(tok0 - 2, h1); ld8(tok0 - 1, h2); }
    for (int i0 = 0; i0 < 32; i0 += 8) {
      uint4 raw[8];
#pragma unroll
      for (int j = 0; j < 8; ++j) raw[j] = *(const uint4*)(ua + (size_t)(tok0 + i0 + j) * 1024 + cg8);
#pragma unroll
      for (int j = 0; j < 8; ++j) {
        float cur[8], o[8];
        uint4 u = raw[j];
        cur[0] = __uint_as_float(u.x << 16); cur[1] = __uint_as_float(u.x & 0xffff0000u);
        cur[2] = __uint_as_float(u.y << 16); cur[3] = __uint_as_float(u.y & 0xffff0000u);
        cur[4] = __uint_as_float(u.z << 16); cur[5] = __uint_as_float(u.z & 0xffff0000u);
        cur[6] = __uint_as_float(u.w << 16); cur[7] = __uint_as_float(u.w & 0xffff0000u);
#pragma unroll
        for (int e = 0; e < 8; ++e) {
          float a = bias[e] + w[0][e] * h0[e] + w[1][e] * h1[e] + w[2][e] * h2[e] + w[3][e] * cur[e];
          o[e] = siluf(a);
          h0[e] = h1[e]; h1[e] = h2[e]; h2[e] = cur[e];
        }
        *(uint4*)(cc + (size_t)(tok0 + i0 + j) * 1024 + cg8) = make_uint4(pk2(o[0], o[1]), pk2(o[2], o[3]), pk2(o[4], o[5]), pk2(o[6], o[7]));
      }
    }
  }
}

constexpr int T3_SCAN = 32, T3_CA = 512, T3_QK = 4096, T3_ALL = T3_SCAN + T3_CA + T3_QK;
DEVI void phase3(const P& p, char* lds, int t) {
  const int tid = tidx(), lane = tid & 63, wid = tid >> 6, wr = wid >> 1, wc = wid & 1, fr = lane & 15, fq = lane >> 4;
  char* ws = p.ws;
  if (t < T3_SCAN) {
    int gid = t * 256 + tid, pp = gid & 63, g = (gid >> 6) & 31, b = gid >> 11;
    S5gp s = s5_gp(p, g, pp);
    float ar, ai; s5_pow(s, 64.f, ar, ai);
    const float* E = (const float*)((char*)p.out + OO_E);
    u16* xp = (u16*)(ws + O_XPREV);
    float xr = 0.f, xi = 0.f;
    for (int c0 = 0; c0 < 128; c0 += 16) {
      float er[16], ei[16];
#pragma unroll
      for (int j = 0; j < 16; ++j) {
        size_t base = ((size_t)(b * 128 + c0 + j) * 32 + g) * 128;
        er[j] = E[base + pp]; ei[j] = E[base + 64 + pp];
      }
#pragma unroll
      for (int j = 0; j < 16; ++j) {
        size_t base = ((size_t)(b * 128 + c0 + j) * 32 + g) * 128;
        xp[base + pp] = f2bf(xr); xp[base + 64 + pp] = f2bf(xi);
        float nr = ar * xr - ai * xi + er[j], ni = ar * xi + ai * xr + ei[j];
        xr = nr; xi = ni;
      }
    }
    return;
  }
  t -= T3_SCAN;
  if (t < T3_CA) {
    int gid = t * 256 + tid, pp = gid & 63, j = (gid >> 6) & 63, g = gid >> 12;
    S5gp s = s5_gp(p, g, pp);
    float er, ei; s5_pow(s, (float)(j + 1), er, ei);
    u16* ca = (u16*)(ws + O_CA);
#pragma unroll
    for (int n = 0; n < 16; ++n) {
      float cr = p.C_re[(g * 16 + n) * 64 + pp], ci = p.C_im[(g * 16 + n) * 64 + pp];
      float zr = cr * er - ci * ei, zi = cr * ei + ci * er;
      size_t o = ((size_t)g * 1024 + j * 16 + n) * 128;
      ca[o + pp] = f2bf(zr); ca[o + 64 + pp] = f2bf(-zi);
    }
    return;
  }
  t -= T3_CA;
  {
    int which = t >> 11, r = t & 2047, mt = r >> 3, h = (r >> 1) & 3, nt = r & 1;
    const u16* A = (const u16*)(ws + O_CC) + (size_t)mt * 128 * 1024 + h * 256;
    const u16* B = (const u16*)(ws + (which == 0 ? O_WQT : O_WKT)) + (size_t)(h * 256 + nt * 128) * 256;
    f32x4 acc[4][4]; zero_acc(acc);
    if (which == 0) {
      gemm_plain<true>(acc, lds, A, 1024, B, 256, 4);
      u16* q = (u16*)(ws + O_QM) + (size_t)mt * 128 * 1024 + h * 256 + nt * 128;
      for_acc<true>(acc, [&](int, int, int rr, int c, f32x4 v) { st_nt8(q + (size_t)rr * 1024 + c, pk4(v)); });
    } else {
      gemm_plain<false>(acc, lds, A, 1024, B, 256, 4);
      int bh = (mt >> 6) * 4 + h, ch = mt & 63, tp0 = ch * 128;
      u16* km = (u16*)(ws + O_KM) + (size_t)mt * 128 * 1024 + h * 256 + nt * 128;
      u16* kts = (u16*)(ws + O_KTS) + (size_t)(bh * 64 + ch) * 32768 + (nt * 128) * 32;
      const float* ksc = (const float*)(ws + O_KSC) + (size_t)bh * LSEQ + tp0;
      float nsum[4] = {0.f, 0.f, 0.f, 0.f};
      f32x4 scv[4];
#pragma unroll
      for (int mi = 0; mi < 4; ++mi) scv[mi] = *(const f32x4*)(ksc + wr * 64 + mi * 16 + fq * 4);
      u16* lt = (u16*)lds;
      for_acc<false>(acc, [&](int mi, int ni, int rr, int c, f32x4 v) {
        f32x4 kv = v * 0.0625f;
#pragma unroll
        for (int j = 0; j < 4; ++j) lt[(rr + j) * 136 + c] = f2bf(kv[j]);
        f32x4 ks = kv * scv[mi];
        *(uint2*)(kts + (size_t)(rr >> 5) * 8192 + c * 32 + (rr & 31)) = pk4(ks);
        nsum[ni] += ks[0] + ks[1] + ks[2] + ks[3];
      });
      __syncthreads();
#pragma unroll
      for (int i = 0; i < 8; ++i) {
        int idx = tid + 256 * i, row = idx >> 4, ch = idx & 15;
        uint4 v = *(const uint4*)(lt + row * 136 + ch * 8);
        *(uint4*)(km + (size_t)row * 1024 + ch * 8) = v;
      }
      float* nlp = (float*)(ws + O_NLP) + ((size_t)(bh * 64 + ch) * 2 + wr) * 256 + nt * 128 + wc * 64;
#pragma unroll
      for (int ni = 0; ni < 4; ++ni) {
        float v = red_fq(nsum[ni]);
        if (fq == 0) nlp[ni * 16 + fr] = v;
      }
    }
  }
}

constexpr int T4_TOEP = 1024, T4_CLOC = 4096, T4_ALL = T4_TOEP + T4_CLOC;
DEVI void phase4(const P& p, char* lds, int t) {
  char* ws = p.ws;
  if (t < T4_TOEP) {
    int nt = 7 - (t >> 7), rem = t & 127, g = rem >> 2, mt = rem & 3;
    f32x4 acc[4][4]; zero_acc(acc);
    const u16* xp = (const u16*)(ws + O_XPREV) + ((size_t)mt * 128 * 32 + g) * 128;
    const u16* ca = (const u16*)(ws + O_CA) + ((size_t)g * 1024 + nt * 128) * 128;
    gemm_plain<true>(acc, lds, xp, 4096, ca, 128, 2);
    const u16* ub = (const u16*)(ws + O_UB) + (size_t)g * 524288 + (size_t)mt * 128 * 1024;
    const u16* km = (const u16*)(ws + O_KMAT) + (size_t)g * 64 * 256;
    const void* zeros = (const void*)(ws + O_BAR + 16384);
    gemm_acc<true>(acc, lds,
                   [=](int r, int k) { return (const void*)(ub + (size_t)r * 1024 + k); },
                   [=](int n, int k) {
                     int col = nt * 128 + n, lag = (col >> 4) - (k >> 4);
                     const void* z = zeros;
                     if (lag >= 0) z = (const void*)(km + ((size_t)lag * 16 + (col & 15)) * 16 + (k & 15));
                     return z;
                   },
                   2 * (nt + 1));
    u16* ys = (u16*)(ws + O_YS5);
    const u16* ubf = (const u16*)(ws + O_UB);
    uint2 upre[4][4]; f32x4 dpre[4];
    for_idx<true>([&](int mi, int ni, int r, int c) {
      int col = nt * 128 + c, j = col >> 4, ch = g * 16 + (col & 15);
      size_t tok = (size_t)(mt * 128 + r) * 64 + j;
      upre[mi][ni] = *(const uint2*)(ubf + ((size_t)g * 32768 + tok) * 16 + (col & 15));
      if (mi == 0) dpre[ni] = *(const f32x4*)(p.D_skip + ch);
    });
    for_acc<true>(acc, [&](int mi, int ni, int r, int c, f32x4 v) {
      int col = nt * 128 + c, j = col >> 4, ch = g * 16 + (col & 15);
      size_t tok = (size_t)(mt * 128 + r) * 64 + j;
      f32x4 u = unpk4(upre[mi][ni]);
      f32x4 d = dpre[ni];
      f32x4 o;
#pragma unroll
      for (int e = 0; e < 4; ++e) o[e] = geluf(v[e] + d[e] * u[e]);
      *(uint2*)(ys + kb32(tok, ch, 512)) = pk4(o);
    });
    return;
  }
  t -= T4_TOEP;
  {
    int bh = t >> 8, c = (t >> 2) & 63, dt = (t >> 1) & 1, et = t & 1;
    const u16* A = (const u16*)(ws + O_VT) + (size_t)(bh * 256 + dt * 128) * LSEQ + c * 128;
    const u16* B = (const u16*)(ws + O_KTS) + (size_t)(bh * 256 + et * 128) * LSEQ + c * 128;
    f32x4 acc[4][4]; zero_acc(acc);
    gemm_plain<true>(acc, lds, A, LSEQ, B, LSEQ, 2);
    u16* cst = (u16*)p.out + ((size_t)(bh * 64 + c) * 256 + dt * 128) * 256 + et * 128;
    for_acc<true>(acc, [&](int, int, int r, int cc, f32x4 v) { *(uint2*)(cst + (size_t)r * 256 + cc) = pk4(v); });
  }
}

constexpr int T5_GLU = 1024, T5_SCAN = 512, T5_NSCAN = 16, T5_ALL = T5_GLU + T5_SCAN + T5_NSCAN;
DEVI void phase5(const P& p, char* lds, int t) {
  const int tid = tidx();
  char* ws = p.ws;
  if (t < T5_GLU) {
    int mt = t >> 2, nt = t & 3;
    const u16* ys = (const u16*)(ws + O_YS5) + (size_t)mt * 128 * 512;
    const u16* wg = (const u16*)(ws + O_WGT) + (size_t)nt * 128 * 512;
    f32x4 acc[4][4]; zero_acc(acc);
    gemm_plain<true>(acc, lds, ys, 512, wg, 512, 8);
    u16* yb = (u16*)(ws + O_YBIN) + (size_t)mt * 128 * 512 + nt * 128;
    uint2 ypre[4][4]; f32x4 bpre[4];
    for_idx<true>([&](int mi, int ni, int r, int c) {
      ypre[mi][ni] = *(const uint2*)(ys + (size_t)r * 512 + nt * 128 + c);
      if (mi == 0) bpre[ni] = *(const f32x4*)(p.b_glu + nt * 128 + c);
    });
    for_acc<true>(acc, [&](int mi, int ni, int r, int c, f32x4 v) {
      f32x4 y = unpk4(ypre[mi][ni]);
      f32x4 bg = bpre[ni];
      f32x4 o;
#pragma unroll
      for (int e = 0; e < 4; ++e) o[e] = y[e] * sigm(v[e] + bg[e]);
      *(uint2*)(yb + (size_t)r * 512 + c) = pk4(o);
    });
    zero_acc(acc);
    const u16* xn = (const u16*)(ws + O_XN) + (size_t)mt * 128 * 1024;
    const u16* wz = (const u16*)(ws + O_WINT) + (size_t)(3584 + nt * 128) * 1024;
    gemm_plain<true>(acc, lds, xn, 1024, wz, 1024, 16);
    for_idx<true>([&](int mi, int ni, int r, int c) { ypre[mi][ni] = *(const uint2*)(yb + (size_t)r * 512 + c); });
    for_acc<true>(acc, [&](int mi, int ni, int r, int c, f32x4 v) {
      f32x4 tt = unpk4(ypre[mi][ni]);
      f32x4 o;
#pragma unroll
      for (int e = 0; e < 4; ++e) o[e] = tt[e] * siluf(v[e]);
      *(uint2*)(yb + (size_t)r * 512 + c) = pk4(o);
    });
    return;
  }
  t -= T5_GLU;
  if (t < T5_SCAN) {
    int gid = t * 256 + tid, bh = gid >> 13, i8 = gid & 8191;
    u16* cst = (u16*)p.out + (size_t)bh * 64 * 65536 + (size_t)i8 * 8;
    const float* ach = (const float*)(ws + O_ACH) + bh * 64;
    float* la = (float*)lds;
    __syncthreads();
    if (tid < 64) la[tid] = ach[tid];
    __syncthreads();
    float st[8];
#pragma unroll
    for (int e = 0; e < 8; ++e) st[e] = 0.f;
    for (int c0 = 0; c0 < 64; c0 += 16) {
      uint4 ub[16];
#pragma unroll
      for (int j = 0; j < 16; ++j) ub[j] = *(const uint4*)(cst + (size_t)(c0 + j) * 65536);
#pragma unroll
      for (int j = 0; j < 16; ++j) {
        uint4 u = ub[j];
        *(uint4*)(cst + (size_t)(c0 + j) * 65536) = make_uint4(pk2(st[0], st[1]), pk2(st[2], st[3]), pk2(st[4], st[5]), pk2(st[6], st[7]));
        float a = la[c0 + j];
        st[0] = a * st[0] + __uint_as_float(u.x << 16); st[1] = a * st[1] + __uint_as_float(u.x & 0xffff0000u);
        st[2] = a * st[2] + __uint_as_float(u.y << 16); st[3] = a * st[3] + __uint_as_float(u.y & 0xffff0000u);
        st[4] = a * st[4] + __uint_as_float(u.z << 16); st[5] = a * st[5] + __uint_as_float(u.z & 0xffff0000u);
        st[6] = a * st[6] + __uint_as_float(u.w << 16); st[7] = a * st[7] + __uint_as_float(u.w & 0xffff0000u);
      }
    }
    return;
  }
}


DEVI void cstate_task(const P& p, char* lds, int task, int vb) {
  const int tid = tidx(), lane = tid & 63, wid = tid >> 6, wr = wid >> 1, wc = wid & 1, fr = lane & 15, fq = lane >> 4;
  char* ws = p.ws;
  const int bh = task >> 2, dt = (task >> 1) & 1, et = task & 1;
  const int nk = 256;
  if (vb == 1) {
    const u16* A = (const u16*)(ws + O_VT) + (size_t)(bh * 64) * 32768 + (dt * 128) * 32;
    const u16* B = (const u16*)(ws + O_KTS) + (size_t)(bh * 64) * 32768 + (et * 128) * 32;
    const int sb = (tid & 63) * 16;
    const int swz = sb ^ (((sb >> 9) & 1) << 5);
    const int R0 = (tid >> 6) * 16 + (swz >> 6);
    const int C0 = (swz & 63) >> 1;
    const int wofs = tid * 16;
    const u16* a0 = A + (size_t)R0 * 32 + C0;
    const u16* a1 = A + (size_t)(R0 + 64) * 32 + C0;
    const u16* b0 = B + (size_t)R0 * 32 + C0;
    const u16* b1 = B + (size_t)(R0 + 64) * 32 + C0;
    asm volatile("s_waitcnt vmcnt(0)" ::: "memory");
    __syncthreads();
#pragma unroll
    for (int s0 = 0; s0 < 7; ++s0) {
      char* sg = lds + s0 * 16384;
      const int ko0 = s0 * 8192;
      glds16(a0 + ko0, sg + wofs); glds16(a1 + ko0, sg + wofs + 4096);
      glds16(b0 + ko0, sg + 8192 + wofs); glds16(b1 + ko0, sg + 8192 + wofs + 4096);
    }
#pragma unroll 1
    for (int ks = 0; ks < nk; ++ks) {
      const int rem = nk - 1 - ks;
      if (rem >= 6) asm volatile("s_waitcnt vmcnt(24)" ::: "memory");
      else if (rem == 5) asm volatile("s_waitcnt vmcnt(20)" ::: "memory");
      else if (rem == 4) asm volatile("s_waitcnt vmcnt(16)" ::: "memory");
      else if (rem == 3) asm volatile("s_waitcnt vmcnt(12)" ::: "memory");
      else if (rem == 2) asm volatile("s_waitcnt vmcnt(8)" ::: "memory");
      else if (rem == 1) asm volatile("s_waitcnt vmcnt(4)" ::: "memory");
      else asm volatile("s_waitcnt vmcnt(0)" ::: "memory");
      __syncthreads();
      if (ks + 7 < nk) {
        char* sg = lds + ((ks + 7) & 7) * 16384;
        const int ko = (ks + 7) * 8192;
        glds16(a0 + ko, sg + wofs); glds16(a1 + ko, sg + wofs + 4096);
        glds16(b0 + ko, sg + 8192 + wofs); glds16(b1 + ko, sg + 8192 + wofs + 4096);
      }
    }
    __syncthreads();
  } else {
    const float achv = ((const float*)(ws + O_ACH))[bh * 64 + lane];
    f32x4 acc[4][4], st[4][4];
    zero_acc(acc); zero_acc(st);
    const int lo = ((fr * 64 + fq * 16) ^ ((fr >> 3) << 5));
    __syncthreads();
#pragma unroll 1
    for (int ks = 0; ks < nk; ++ks) {
      __syncthreads();
      const char* cur = lds + (ks & 7) * 16384;
      bf16x8 af[4], bfr[4];
#pragma unroll
      for (int mi = 0; mi < 4; ++mi) af[mi] = *(const bf16x8*)(cur + (wr * 4 + mi) * 1024 + lo);
#pragma unroll
      for (int ni = 0; ni < 4; ++ni) bfr[ni] = *(const bf16x8*)(cur + 8192 + (wc * 4 + ni) * 1024 + lo);
#pragma unroll
      for (int mi = 0; mi < 4; ++mi)
#pragma unroll
        for (int ni = 0; ni < 4; ++ni) acc[mi][ni] = __builtin_amdgcn_mfma_f32_16x16x32_bf16(bfr[ni], af[mi], acc[mi][ni], 0, 0, 0);
      if ((ks & 3) == 3) {
        const int c = ks >> 2;
        const float a = __shfl(achv, c);
        u16* cst = (u16*)p.out + ((size_t)(bh * 64 + c) * 256 + dt * 128 + wr * 64 + fr) * 256 + et * 128 + wc * 64 + fq * 4;
#pragma unroll
        for (int mi = 0; mi < 4; ++mi)
#pragma unroll
          for (int ni = 0; ni < 4; ++ni) {
            *(uint2*)(cst + (size_t)(mi * 16) * 256 + ni * 16) = pk4(st[mi][ni]);
            st[mi][ni] = st[mi][ni] * a + acc[mi][ni];
            acc[mi][ni] = f32x4{0.f, 0.f, 0.f, 0.f};
          }
      }
    }
    __syncthreads();
  }
}


DEVI void wait_vm_even(int n) {
  switch (n) {
    case 0: asm volatile("s_waitcnt vmcnt(0)" ::: "memory"); break;
    case 2: asm volatile("s_waitcnt vmcnt(2)" ::: "memory"); break;
    case 4: asm volatile("s_waitcnt vmcnt(4)" ::: "memory"); break;
    case 6: asm volatile("s_waitcnt vmcnt(6)" ::: "memory"); break;
    case 8: asm volatile("s_waitcnt vmcnt(8)" ::: "memory"); break;
    case 10: asm volatile("s_waitcnt vmcnt(10)" ::: "memory"); break;
    case 12: asm volatile("s_waitcnt vmcnt(12)" ::: "memory"); break;
    case 14: asm volatile("s_waitcnt vmcnt(14)" ::: "memory"); break;
    case 16: asm volatile("s_waitcnt vmcnt(16)" ::: "memory"); break;
    case 18: asm volatile("s_waitcnt vmcnt(18)" ::: "memory"); break;
    case 20: asm volatile("s_waitcnt vmcnt(20)" ::: "memory"); break;
    case 22: asm volatile("s_waitcnt vmcnt(22)" ::: "memory"); break;
    case 24: asm volatile("s_waitcnt vmcnt(24)" ::: "memory"); break;
    case 26: asm volatile("s_waitcnt vmcnt(26)" ::: "memory"); break;
    default: asm volatile("s_waitcnt vmcnt(28)" ::: "memory"); break;
  }
}
DEVI void cstate64_task(const P& p, char* lds, int task, int vb) {
  const int tid = tidx(), lane = tid & 63, wid = tid >> 6, wr = wid >> 1, wc = wid & 1, fr = lane & 15, fq = lane >> 4;
  char* ws = p.ws;
  const int bh = task >> 4, dt = (task >> 2) & 3, et = task & 3;
  const int nk = 256;
  if (vb == 1) {
    const int sb = (tid & 63) * 16;
    const int swz = sb ^ (((sb >> 9) & 1) << 5);
    const int R = (tid >> 6) * 16 + (swz >> 6);
    const int C = (swz & 63) >> 1;
    const u16* a0 = (const u16*)(ws + O_VT) + (size_t)(bh * 64) * 32768 + (dt * 64 + R) * 32 + C;
    const u16* b0 = (const u16*)(ws + O_KTS) + (size_t)(bh * 64) * 32768 + (et * 64 + R) * 32 + C;
    const int wofs = tid * 16;
    asm volatile("s_waitcnt vmcnt(0)" ::: "memory");
    __syncthreads();
#pragma unroll
    for (int s0 = 0; s0 < 15; ++s0) {
      char* sg = lds + s0 * 8192;
      glds16(a0 + s0 * 8192, sg + wofs); glds16(b0 + s0 * 8192, sg + 4096 + wofs);
    }
#pragma unroll 1
    for (int ks = 0; ks < nk; ++ks) {
      const int rem = nk - 1 - ks;
      wait_vm_even(rem >= 14 ? 28 : 2 * rem);
      __syncthreads();
      if (ks + 15 < nk) {
        char* sg = lds + ((ks + 15) & 15) * 8192;
        glds16(a0 + (size_t)(ks + 15) * 8192, sg + wofs); glds16(b0 + (size_t)(ks + 15) * 8192, sg + 4096 + wofs);
      }
    }
    __syncthreads();
  } else {
    const float achv = ((const float*)(ws + O_ACH))[bh * 64 + lane];
    f32x4 acc[2][2], st[2][2];
#pragma unroll
    for (int i = 0; i < 2; ++i)
#pragma unroll
      for (int j = 0; j < 2; ++j) { acc[i][j] = f32x4{0.f, 0.f, 0.f, 0.f}; st[i][j] = f32x4{0.f, 0.f, 0.f, 0.f}; }
    const int lo = ((fr * 64 + fq * 16) ^ ((fr >> 3) << 5));
    __syncthreads();
#pragma unroll 1
    for (int ks = 0; ks < nk; ++ks) {
      __syncthreads();
      const char* cur = lds + (ks & 15) * 8192;
      bf16x8 af[2], bfr[2];
#pragma unroll
      for (int mi = 0; mi < 2; ++mi) af[mi] = *(const bf16x8*)(cur + (wr * 2 + mi) * 1024 + lo);
#pragma unroll
      for (int ni = 0; ni < 2; ++ni) bfr[ni] = *(const bf16x8*)(cur + 4096 + (wc * 2 + ni) * 1024 + lo);
#pragma unroll
      for (int mi = 0; mi < 2; ++mi)
#pragma unroll
        for (int ni = 0; ni < 2; ++ni) acc[mi][ni] = __builtin_amdgcn_mfma_f32_16x16x32_bf16(bfr[ni], af[mi], acc[mi][ni], 0, 0, 0);
      if ((ks & 3) == 3) {
        const int c = ks >> 2;
        const float a = __shfl(achv, c);
        u16* cst = (u16*)p.out + ((size_t)(bh * 64 + c) * 256 + dt * 64 + wr * 32 + fr) * 256 + et * 64 + wc * 32 + fq * 4;
#pragma unroll
        for (int mi = 0; mi < 2; ++mi)
#pragma unroll
          for (int ni = 0; ni < 2; ++ni) {
            st_nt8(cst + (size_t)(mi * 16) * 256 + ni * 16, pk4(st[mi][ni]));
            st[mi][ni] = st[mi][ni] * a + acc[mi][ni];
            acc[mi][ni] = f32x4{0.f, 0.f, 0.f, 0.f};
          }
      }
    }
    __syncthreads();
  }
}

DEVI void nscan_tile(const P& p, char* lds, int t) {
  const int tid = tidx();
  char* ws = p.ws;
  {
    int bh = t, e = tid;
    const float* nlp = (const float*)(ws + O_NLP) + (size_t)bh * 64 * 512;
    float* np = (float*)(ws + O_NPREV) + (size_t)bh * 64 * 256;
    const float* ach = (const float*)(ws + O_ACH) + bh * 64;
    float* la = (float*)lds;
    __syncthreads();
    if (tid < 64) la[tid] = ach[tid];
    __syncthreads();
    float st = 0.f;
    for (int c0 = 0; c0 < 64; c0 += 16) {
      float n0[16], n1[16];
#pragma unroll
      for (int j = 0; j < 16; ++j) { n0[j] = nlp[(c0 + j) * 512 + e]; n1[j] = nlp[(c0 + j) * 512 + 256 + e]; }
#pragma unroll
      for (int j = 0; j < 16; ++j) {
        np[(c0 + j) * 256 + e] = st;
        st = la[c0 + j] * st + n0[j] + n1[j];
      }
    }
  }
}

DEVI void phase6(const P& p, char* lds, int t) {
  const int tid = tidx(), lane = tid & 63, wid = tid >> 6, wr = wid >> 1, wc = wid & 1, fr = lane & 15, fq = lane >> 4;
  char* ws = p.ws;
  int bh = t >> 6, c = t & 63, b = bh >> 2, h = bh & 3;
  size_t tok0 = (size_t)b * LSEQ + c * 128;
  const u16* Q = (const u16*)(ws + O_QM) + tok0 * 1024 + h * 256;
  const u16* K = (const u16*)(ws + O_KM) + tok0 * 1024 + h * 256;
  f32x4 acc[4][4]; zero_acc(acc);
  gemm_plain<true>(acc, lds, Q, 1024, K, 1024, 4);
  const size_t g0 = (size_t)bh * LSEQ + c * 128;
  const float* alpha = (const float*)(ws + O_ALPHA) + g0;
  const float* rs = (const float*)(ws + O_RS) + g0;
  u16* pm = (u16*)(ws + O_PMAT) + g0 * 128;
  float rowp[4] = {0.f, 0.f, 0.f, 0.f};
  float alp[4]; f32x4 rvp[4];
#pragma unroll
  for (int i = 0; i < 4; ++i) { alp[i] = alpha[wr * 64 + i * 16 + fr]; rvp[i] = *(const f32x4*)(rs + wc * 64 + i * 16 + fq * 4); }
  for_acc<true>(acc, [&](int mi, int ni, int r, int cc, f32x4 v) {
    float al = alp[mi];
    f32x4 rv = rvp[ni];
    f32x4 o;
#pragma unroll
    for (int e = 0; e < 4; ++e) {
      float d = (cc + e <= r) ? __expf(al + rv[e]) : 0.f;
      o[e] = v[e] * d;
    }
    rowp[mi] += o[0] + o[1] + o[2] + o[3];
    *(uint2*)(pm + (size_t)r * 128 + cc) = pk4(o);
  });
  float* lf = (float*)lds;
#pragma unroll
  for (int mi = 0; mi < 4; ++mi) {
    float v = red_fq(rowp[mi]);
    if (fq == 0) lf[wc * 128 + wr * 64 + mi * 16 + fr] = v;
  }
  __syncthreads();
  {
    int tt = tid >> 1, hf = tid & 1;
    const u16* qrow = Q + (size_t)tt * 1024 + hf * 128;
    const float* np = (const float*)(ws + O_NPREV) + (size_t)(bh * 64 + c) * 256 + hf * 128;
    float dot = 0.f;
#pragma unroll 4
    for (int i = 0; i < 16; ++i) {
      uint4 u = *(const uint4*)(qrow + i * 8);
      float4 n0 = *(const float4*)(np + i * 8), n1 = *(const float4*)(np + i * 8 + 4);
      dot += __uint_as_float(u.x << 16) * n0.x + __uint_as_float(u.x & 0xffff0000u) * n0.y +
             __uint_as_float(u.y << 16) * n0.z + __uint_as_float(u.y & 0xffff0000u) * n0.w +
             __uint_as_float(u.z << 16) * n1.x + __uint_as_float(u.z & 0xffff0000u) * n1.y +
             __uint_as_float(u.w << 16) * n1.z + __uint_as_float(u.w & 0xffff0000u) * n1.w;
    }
    dot += __shfl_xor(dot, 1);
    if (hf == 0) {
      float inter = ((const float*)(ws + O_INTER))[g0 + tt];
      float emt = ((const float*)(ws + O_EMT))[g0 + tt];
      float den = lf[tt] + lf[128 + tt] + inter * dot;
      ((float*)(ws + O_RDEN))[g0 + tt] = 1.f / fmaxf(fabsf(den), emt);
    }
  }
}

DEVI void phase7(const P& p, char* lds, int t) {
  const int tid = tidx(), lane = tid & 63, wid = tid >> 6, wr = wid >> 1, fr = lane & 15;
  char* ws = p.ws;
  int bh = t >> 7, c = (t >> 1) & 63, dt = t & 1, b = bh >> 2, h = bh & 3;
  size_t tok0 = (size_t)b * LSEQ + c * 128;
  const size_t g0 = (size_t)bh * LSEQ + c * 128;
  const u16* Q = (const u16*)(ws + O_QM) + tok0 * 1024 + h * 256;
  const u16* Cp = (const u16*)p.out + ((size_t)(bh * 64 + c) * 256 + dt * 128) * 256;
  f32x4 acc[4][4]; zero_acc(acc);
  gemm_plain<true>(acc, lds, Q, 1024, Cp, 256, 4);
  const float* inter = (const float*)(ws + O_INTER) + g0;
#pragma unroll
  for (int mi = 0; mi < 4; ++mi) {
    float it = inter[wr * 64 + mi * 16 + fr];
#pragma unroll
    for (int ni = 0; ni < 4; ++ni) acc[mi][ni] *= it;
  }
  const u16* pm = (const u16*)(ws + O_PMAT) + g0 * 128;
  const u16* vt = (const u16*)(ws + O_VT) + (size_t)(bh * 64 + c) * 32768 + (dt * 128) * 32;
  gemm_acc<true>(acc, lds, [=](int r, int k) { return (const void*)(pm + (size_t)r * 128 + k); },
                 [=](int n, int k) { return (const void*)(vt + (size_t)(k >> 5) * 8192 + n * 32 + (k & 31)); }, 2);
  const float* rden = (const float*)(ws + O_RDEN) + g0;
  u16* hb = (u16*)(ws + O_HBUF);
  float rdp[4];
#pragma unroll
  for (int i = 0; i < 4; ++i) rdp[i] = rden[wr * 64 + i * 16 + fr];
  for_acc<true>(acc, [&](int mi, int, int r, int cc, f32x4 v) {
    *(uint2*)(hb + kb32(tok0 + r, h * 256 + dt * 128 + cc, 1024)) = pk4(v * rdp[mi]);
  });
}

DEVI void phase75(const P& p, char* lds, int t) {
  const int tid = tidx(), lane = tid & 63, wid = tid >> 6, wr = wid >> 1, wc = wid & 1, fr = lane & 15, fq = lane >> 4;
  char* ws = p.ws;
  int mt = t >> 3, nt = t & 7;
  const u16* xn = (const u16*)(ws + O_XN) + (size_t)mt * 128 * 1024;
  const u16* w = (const u16*)(ws + O_WINT) + (size_t)(2048 + nt * 128) * 1024;
  f32x4 acc[4][4]; zero_acc(acc);
  gemm_plain<true>(acc, lds, xn, 1024, w, 1024, 16);
  u16* hb = (u16*)(ws + O_HBUF) + (size_t)mt * 128 * 1024 + nt * 128;
  float sq[4] = {0.f, 0.f, 0.f, 0.f};
  uint2 hpre[4][4];
  for_idx<true>([&](int mi, int ni, int r, int c) { hpre[mi][ni] = *(const uint2*)(hb + (size_t)r * 1024 + c); });
  for_acc<true>(acc, [&](int mi, int ni, int r, int c, f32x4 v) {
    f32x4 hv = unpk4(hpre[mi][ni]);
    f32x4 o;
#pragma unroll
    for (int e = 0; e < 4; ++e) { o[e] = sigm(v[e]) * hv[e]; sq[mi] += o[e] * o[e]; }
    *(uint2*)(hb + (size_t)r * 1024 + c) = pk4(o);
  });
  float* hs = (float*)(ws + O_HSQP);
#pragma unroll
  for (int mi = 0; mi < 4; ++mi) {
    float v = red_fq(sq[mi]);
    if (fq == 0) hs[(size_t)(mt * 128 + wr * 64 + mi * 16 + fr) * 16 + (nt >> 1) * 4 + (nt & 1) * 2 + wc] = v;
  }
}
DEVI void phase8(const P& p, char* lds, int t) {
  char* ws = p.ws;
  int mt = t >> 3, nt = t & 7;
  const u16* xn = (const u16*)(ws + O_XN) + (size_t)mt * 128 * 1024;
  const u16* w = (const u16*)(ws + O_WINT) + (size_t)(1024 + nt * 128) * 1024;
  f32x4 acc[4][4]; zero_acc(acc);
  gemm_plain<true>(acc, lds, xn, 1024, w, 1024, 16);
  u16* hb = (u16*)(ws + O_HBUF) + (size_t)mt * 128 * 1024 + nt * 128;
  const u16* cc = (const u16*)(ws + O_CC) + (size_t)mt * 128 * 1024 + nt * 128;
  const float* hs = (const float*)(ws + O_HSQP);
  uint2 hpre[4][4], cpre[4][4]; float rsp[4]; f32x4 hgp[4], skp[4];
  for_idx<true>([&](int mi, int ni, int r, int c) {
    hpre[mi][ni] = *(const uint2*)(hb + (size_t)r * 1024 + c);
    cpre[mi][ni] = *(const uint2*)(cc + (size_t)r * 1024 + c);
    if (ni == 0) {
      float4 s4 = *(const float4*)(hs + (size_t)(mt * 128 + r) * 16 + (nt >> 1) * 4);
      rsp[mi] = rsqrtf((s4.x + s4.y + s4.z + s4.w) * (1.f / 256.f) + 1e-6f);
    }
    if (mi == 0) { hgp[ni] = *(const f32x4*)(p.head_g + nt * 128 + c); skp[ni] = *(const f32x4*)(p.skip_a + nt * 128 + c); }
  });
  for_acc<true>(acc, [&](int mi, int ni, int r, int c, f32x4 v) {
    float rstd = rsp[mi];
    f32x4 hv = unpk4(hpre[mi][ni]);
    f32x4 cv = unpk4(cpre[mi][ni]);
    f32x4 hg = hgp[ni];
    f32x4 sk = skp[ni];
    f32x4 o;
#pragma unroll
    for (int e = 0; e < 4; ++e) o[e] = siluf(v[e]) * (hv[e] * rstd * hg[e] + sk[e] * cv[e]);
    *(uint2*)(hb + (size_t)r * 1024 + c) = pk4(o);
  });
}
DEVI void phase85(const P& p, char* lds, int t) {
  char* ws = p.ws;
  int mt = t >> 4, nt = t & 15;
  const u16* xn = (const u16*)(ws + O_XN) + (size_t)mt * 128 * 1024;
  const u16* w = (const u16*)(ws + O_WINT) + (size_t)(4096 + nt * 128) * 1024;
  f32x4 acc[4][4]; zero_acc(acc);
  gemm_plain<true>(acc, lds, xn, 1024, w, 1024, 16);
  u16* sg = (u16*)(ws + O_SG) + (size_t)mt * 128 * 2048 + nt * 128;
  for_acc<true>(acc, [&](int, int, int r, int c, f32x4 v) {
    f32x4 o;
#pragma unroll
    for (int e = 0; e < 4; ++e) o[e] = sigm(v[e]);
    *(uint2*)(sg + (size_t)r * 2048 + c) = pk4(o);
  });
}
DEVI void phase9(const P& p, char* lds, int t) {
  char* ws = p.ws;
  int mt = t >> 3, nt = t & 7;
  const u16* yb = (const u16*)(ws + O_YBIN) + (size_t)mt * 128 * 512;
  const u16* wb = (const u16*)(ws + O_WBT) + (size_t)nt * 128 * 512;
  f32x4 acc[4][4]; zero_acc(acc);
  gemm_plain<true>(acc, lds, yb, 512, wb, 512, 8);
  const u16* sg = (const u16*)(ws + O_SG) + (size_t)mt * 128 * 2048 + nt * 128;
  for_acc<true>(acc, [&](int mi, int ni, int r, int c, f32x4 v) {
    f32x4 ga = unpk4(*(const uint2*)(sg + (size_t)r * 2048 + c));
    f32x4 gb = unpk4(*(const uint2*)(sg + (size_t)r * 2048 + 1024 + c));
#pragma unroll
    for (int e = 0; e < 4; ++e) acc[mi][ni][e] = v[e] * gb[e] / ga[e];
  });
  const u16* ya = (const u16*)(ws + O_HBUF) + (size_t)mt * 128 * 1024;
  const u16* wa = (const u16*)(ws + O_WAT) + (size_t)nt * 128 * 1024;
  gemm_plain<true>(acc, lds, ya, 1024, wa, 1024, 16);
  u16* mg = (u16*)(ws + O_MERGED) + (size_t)mt * 128 * 1024 + nt * 128;
  uint2 gpre[4][4];
  for_idx<true>([&](int mi, int ni, int r, int c) { gpre[mi][ni] = *(const uint2*)(sg + (size_t)r * 2048 + c); });
  for_acc<true>(acc, [&](int mi, int ni, int r, int c, f32x4 v) {
    f32x4 ga = unpk4(gpre[mi][ni]);
    *(uint2*)(mg + (size_t)r * 1024 + c) = pk4(v * ga);
  });
}
DEVI void phase10(const P& p, char* lds, int t) {
  const int tid = tidx(), lane = tid & 63, wid = tid >> 6, wr = wid >> 1, wc = wid & 1, fr = lane & 15, fq = lane >> 4;
  char* ws = p.ws;
  int mt = t >> 3, nt = t & 7;
  const u16* mg = (const u16*)(ws + O_MERGED) + (size_t)mt * 128 * 1024;
  const u16* wo = (const u16*)(ws + O_WOT) + (size_t)nt * 128 * 1024;
  f32x4 acc[4][4]; zero_acc(acc);
  gemm_plain<true>(acc, lds, mg, 1024, wo, 1024, 16);
  float* o = p.out + (size_t)mt * 128 * 1024 + nt * 128;
  float sq[4] = {0.f, 0.f, 0.f, 0.f};
  for_acc<true>(acc, [&](int mi, int, int r, int c, f32x4 v) {
    *(f32x4*)(o + (size_t)r * 1024 + c) = v;
    sq[mi] += v[0] * v[0] + v[1] * v[1] + v[2] * v[2] + v[3] * v[3];
  });
  float* rq = (float*)(ws + O_RSQP);
#pragma unroll
  for (int mi = 0; mi < 4; ++mi) {
    float v = red_fq(sq[mi]);
    if (fq == 0) rq[(size_t)(mt * 128 + wr * 64 + mi * 16 + fr) * 16 + nt * 2 + wc] = v;
  }
}
DEVI void phase11(const P& p, int t) {
  const int tid = tidx(), lane = tid & 63;
  size_t row = (size_t)t * 4 + (tid >> 6);
  const float* rq = (const float*)(p.ws + O_RSQP) + row * 16;
  float4 a = *(const float4*)(rq), b = *(const float4*)(rq + 4), c = *(const float4*)(rq + 8), d = *(const float4*)(rq + 12);
  float ss = ((a.x + a.y) + (a.z + a.w)) + ((b.x + b.y) + (b.z + b.w)) + ((c.x + c.y) + (c.z + c.w)) + ((d.x + d.y) + (d.z + d.w));
  float rstd = rsqrtf(ss * (1.f / 1024.f) + 1e-6f);
  float4 rr[4], xx[4], gg[4];
#pragma unroll
  for (int j = 0; j < 4; ++j) {
    int k = j * 256 + lane * 4;
    f32x4 r4 = unpk4(*(const uint2*)((const u16*)(p.ws + O_R16) + row * 1024 + k));
    rr[j] = make_float4(r4[0], r4[1], r4[2], r4[3]);
    xx[j] = *(const float4*)(p.x + row * 1024 + k);
    gg[j] = *(const float4*)(p.norm_post_g + k);
  }
#pragma unroll
  for (int j = 0; j < 4; ++j) {
    int k = j * 256 + lane * 4;
    float4 r = rr[j], xv = xx[j], g = gg[j];
    float4 o = make_float4(xv.x + r.x * rstd * g.x, xv.y + r.y * rstd * g.y, xv.z + r.z * rstd * g.z, xv.w + r.w * rstd * g.w);
    *(float4*)(p.out + row * 1024 + k) = o;
  }
}


DEVI void b_phase1(const P& p, char* lds, int t) {
  char* ws = p.ws;
  int mt = t / 6, nt = t % 6;
  const u16* A = (const u16*)(ws + O_XN) + (size_t)mt * 32 * 8192;
  int wrow = nt < 4 ? nt * 256 : 3072 + (nt - 4) * 256;
  const u16* B = (const u16*)(ws + O_WINT) + (size_t)(wrow >> 8) * 32 * 8192;
  f32x4 acc[8][4]; zero_acc8(acc);
  gemm8_kb(acc, lds, A, B, 32);
  if (nt < 4) {
    u16* dst = (u16*)(ws + O_UA) + (size_t)mt * 256 * 1024 + nt * 256;
    epi8(acc, [&](int, int, int, int) {}, [&](int, int, int, int r, int c, f32x4& v) { *(uint2*)(dst + (size_t)r * 1024 + c) = pk4(v); });
  } else {
    u16* ubg = (u16*)(ws + O_UB);
    epi8(acc, [&](int, int, int, int) {}, [&](int, int, int, int r, int c, f32x4& v) {
      int ch = (nt - 4) * 256 + c;
      *(uint2*)(ubg + ((size_t)(ch >> 4) * 32768 + (size_t)mt * 256 + r) * 16 + (ch & 15)) = pk4(v);
    });
  }
}
DEVI void b_glu(const P& p, char* lds, int t) {
  char* ws = p.ws;
  int mt = t >> 1, nt = t & 1;
  const u16* ys = (const u16*)(ws + O_YS5) + (size_t)mt * 16 * 8192;
  const u16* wg = (const u16*)(ws + O_WGT) + (size_t)nt * 16 * 8192;
  f32x4 acc[8][4]; zero_acc8(acc);
  gemm8_kb(acc, lds, ys, wg, 16);
  u16* yb = (u16*)(ws + O_YBIN) + (size_t)mt * 16 * 8192;
  uint2 ypre[4][4]; f32x4 bpre[4];
  epi8<2>(acc,
       [&](int m, int ni, int r, int c) {
         ypre[m][ni] = *(const uint2*)(ys + kb32(r, nt * 256 + c, 512));
         if (m == 0) bpre[ni] = *(const f32x4*)(p.b_glu + nt * 256 + c);
       },
       [&](int m, int, int ni, int r, int c, f32x4& v) {
         f32x4 y = unpk4(ypre[m][ni]), bg = bpre[ni], o;
#pragma unroll
         for (int e = 0; e < 4; ++e) o[e] = y[e] * sigm(v[e] + bg[e]);
         *(uint2*)(yb + kb32(r, nt * 256 + c, 512)) = pk4(o);
       });
  zero_acc8(acc);
  const u16* xn = (const u16*)(ws + O_XN) + (size_t)mt * 32 * 8192;
  const u16* wz = (const u16*)(ws + O_WINT) + (size_t)(14 + nt) * 32 * 8192;
  gemm8_kb(acc, lds, xn, wz, 32);
  epi8<2>(acc, [&](int m, int ni, int r, int c) { ypre[m][ni] = *(const uint2*)(yb + kb32(r, nt * 256 + c, 512)); },
       [&](int m, int, int ni, int r, int c, f32x4& v) {
         f32x4 tt = unpk4(ypre[m][ni]), o;
#pragma unroll
         for (int e = 0; e < 4; ++e) o[e] = tt[e] * siluf(v[e]);
         *(uint2*)(yb + kb32(r, nt * 256 + c, 512)) = pk4(o);
       });
}
DEVI void b_phase75(const P& p, char* lds, int t, bool dry = false) {
  const int tid = tidx512(), lane = tid & 63, wid = tid >> 6, wr = wid >> 2, wc = wid & 3, fr = lane & 15, fq = lane >> 4;
  char* ws = p.ws;
  int mt = t >> 2, nt = t & 3;
  const u16* xn = (const u16*)(ws + O_XN) + (size_t)mt * 32 * 8192;
  const u16* w = (const u16*)(ws + O_WINT) + (size_t)(8 + nt) * 32 * 8192;
  f32x4 acc[8][4]; zero_acc8(acc);
  gemm8_kb(acc, lds, xn, w, 32);
  u16* hb = (u16*)(ws + O_HBUF) + (size_t)mt * 32 * 8192;
  u16* hbw = dry ? (u16*)(ws + O_QM) + (size_t)mt * 32 * 8192 : hb;
  float sq[8] = {0.f, 0.f, 0.f, 0.f, 0.f, 0.f, 0.f, 0.f};
  uint2 hpre[4][4];
  epi8<2>(acc, [&](int m, int ni, int r, int c) { hpre[m][ni] = *(const uint2*)(hb + kb32(r, nt * 256 + c, 1024)); },
       [&](int m, int mg, int ni, int r, int c, f32x4& v) {
         f32x4 hv = unpk4(hpre[m][ni]), o;
#pragma unroll
         for (int e = 0; e < 4; ++e) { o[e] = sigm(v[e]) * hv[e]; sq[mg] += o[e] * o[e]; }
         *(uint2*)(hbw + kb32(r, nt * 256 + c, 1024)) = pk4(o);
       });
  float* hs = dry ? (float*)(ws + O_KM) : (float*)(ws + O_HSQP);
#pragma unroll
  for (int mg = 0; mg < 8; ++mg) {
    float v = red_fq(sq[mg]);
    if (fq == 0) hs[(size_t)(mt * 256 + wr * 128 + mg * 16 + fr) * 16 + nt * 4 + wc] = v;
  }
}
DEVI void b_phase8(const P& p, char* lds, int t, bool dry = false) {
  char* ws = p.ws;
  int mt = t >> 2, nt = t & 3;
  const u16* xn = (const u16*)(ws + O_XN) + (size_t)mt * 32 * 8192;
  const u16* w = (const u16*)(ws + O_WINT) + (size_t)(4 + nt) * 32 * 8192;
  f32x4 acc[8][4]; zero_acc8(acc);
  gemm8_kb(acc, lds, xn, w, 32);
  u16* hb = (u16*)(ws + O_HBUF) + (size_t)mt * 32 * 8192;
  u16* hbw = dry ? (u16*)(ws + O_QM) + (size_t)mt * 32 * 8192 : hb;
  const u16* cc = (const u16*)(ws + O_CC) + (size_t)mt * 256 * 1024 + nt * 256;
  const float* hs = (const float*)(ws + O_HSQP);
  uint2 hpre[4][4], cpre[4][4]; float rsp[4]; f32x4 hgp[4], skp[4];
  epi8<1>(acc,
       [&](int m, int ni, int r, int c) {
         hpre[m][ni] = *(const uint2*)(hb + kb32(r, nt * 256 + c, 1024));
         cpre[m][ni] = *(const uint2*)(cc + (size_t)r * 1024 + c);
         if (ni == 0) {
           float4 s4 = *(const float4*)(hs + (size_t)(mt * 256 + r) * 16 + nt * 4);
           rsp[m] = rsqrtf((s4.x + s4.y + s4.z + s4.w) * (1.f / 256.f) + 1e-6f);
         }
         if (m == 0) { hgp[ni] = *(const f32x4*)(p.head_g + nt * 256 + c); skp[ni] = *(const f32x4*)(p.skip_a + nt * 256 + c); }
       },
       [&](int m, int, int ni, int r, int c, f32x4& v) {
         float rstd = rsp[m];
         f32x4 hv = unpk4(hpre[m][ni]), cv = unpk4(cpre[m][ni]), hg = hgp[ni], sk = skp[ni], o;
#pragma unroll
         for (int e = 0; e < 4; ++e) o[e] = siluf(v[e]) * (hv[e] * rstd * hg[e] + sk[e] * cv[e]);
         *(uint2*)(hbw + kb32(r, nt * 256 + c, 1024)) = pk4(o);
       });
}
DEVI void b_phase85(const P& p, char* lds, int t) {
  char* ws = p.ws;
  int mt = t >> 3, nt = t & 7;
  const u16* xn = (const u16*)(ws + O_XN) + (size_t)mt * 32 * 8192;
  const u16* w = (const u16*)(ws + O_WINT) + (size_t)(16 + nt) * 32 * 8192;
  f32x4 acc[8][4]; zero_acc8(acc);
  gemm8_kb(acc, lds, xn, w, 32);
  u16* sg = (u16*)(ws + O_SG) + (size_t)mt * 256 * 2048 + nt * 256;
  epi8(acc, [&](int, int, int, int) {}, [&](int, int, int, int r, int c, f32x4& v) {
    f32x4 o;
#pragma unroll
    for (int e = 0; e < 4; ++e) o[e] = sigm(v[e]);
    *(uint2*)(sg + (size_t)r * 2048 + c) = pk4(o);
  });
}
DEVI void b_phase9(const P& p, char* lds, int t) {
  char* ws = p.ws;
  int mt = t >> 2, nt = t & 3;
  const u16* yb = (const u16*)(ws + O_YBIN) + (size_t)mt * 16 * 8192;
  const u16* wb = (const u16*)(ws + O_WBT) + (size_t)nt * 16 * 8192;
  f32x4 acc[8][4]; zero_acc8(acc);
  gemm8_kb(acc, lds, yb, wb, 16);
  const u16* sg = (const u16*)(ws + O_SG) + (size_t)mt * 256 * 2048 + nt * 256;
  u16* mg = (u16*)(ws + O_MERGED) + (size_t)mt * 32 * 8192;
  uint2 gp[4][4], tp[4][4];
  epi8<2>(acc, [&](int m, int ni, int r, int c) { gp[m][ni] = *(const uint2*)(sg + (size_t)r * 2048 + 1024 + c); },
       [&](int m, int, int ni, int r, int c, f32x4& v) {
         f32x4 gb = unpk4(gp[m][ni]);
         *(uint2*)(mg + kb32(r, nt * 256 + c, 1024)) = pk4(v * gb);
       });
  zero_acc8(acc);
  const u16* ya = (const u16*)(ws + O_HBUF) + (size_t)mt * 32 * 8192;
  const u16* wa = (const u16*)(ws + O_WAT) + (size_t)nt * 32 * 8192;
  gemm8_kb(acc, lds, ya, wa, 32);
  epi8<2>(acc,
       [&](int m, int ni, int r, int c) {
         gp[m][ni] = *(const uint2*)(sg + (size_t)r * 2048 + c);
         tp[m][ni] = *(const uint2*)(mg + kb32(r, nt * 256 + c, 1024));
       },
       [&](int m, int, int ni, int r, int c, f32x4& v) {
         f32x4 ga = unpk4(gp[m][ni]), tt = unpk4(tp[m][ni]);
         *(uint2*)(mg + kb32(r, nt * 256 + c, 1024)) = pk4(v * ga + tt);
       });
}
DEVI void b_phase10(const P& p, char* lds, int t) {
  const int tid = tidx512(), lane = tid & 63, wid = tid >> 6, wr = wid >> 2, wc = wid & 3, fr = lane & 15, fq = lane >> 4;
  char* ws = p.ws;
  int mt = t >> 2, nt = t & 3;
  const u16* mg = (const u16*)(ws + O_MERGED) + (size_t)mt * 32 * 8192;
  const u16* wo = (const u16*)(ws + O_WOT) + (size_t)nt * 32 * 8192;
  f32x4 acc[8][4]; zero_acc8(acc);
  gemm8_kb(acc, lds, mg, wo, 32);
  float* rq = (float*)(ws + O_RSQP);
#pragma unroll
  for (int mg2 = 0; mg2 < 8; ++mg2) {
    float sq = 0.f;
#pragma unroll
    for (int ni = 0; ni < 4; ++ni) { f32x4 v = acc[mg2][ni]; sq += v[0] * v[0] + v[1] * v[1] + v[2] * v[2] + v[3] * v[3]; }
    sq = red_fq(sq);
    if (fq == 0) rq[(size_t)(mt * 256 + wr * 128 + mg2 * 16 + fr) * 16 + nt * 4 + wc] = sq;
  }
  asm volatile("s_waitcnt vmcnt(0)" ::: "memory");
  __syncthreads();
  if (threadIdx.x == 0) {
    unsigned* cnt = (unsigned*)(ws + O_BAR + 32768) + mt * 16;
    unsigned* bar = (unsigned*)(ws + O_BAR);
    __builtin_amdgcn_fence(__ATOMIC_RELEASE, "agent");
    asm volatile("s_waitcnt vmcnt(0)" ::: "memory");
    xb_add(cnt, 1u);
    XB_SPIN(xb_ld(cnt) < 4u, bar);
    __builtin_amdgcn_fence(__ATOMIC_ACQUIRE, "agent");
    asm volatile("s_waitcnt vmcnt(0)" ::: "memory");
  }
  __syncthreads();
  float rstd[8];
#pragma unroll
  for (int mg2 = 0; mg2 < 8; ++mg2) {
    const float* q = rq + (size_t)(mt * 256 + wr * 128 + mg2 * 16 + fr) * 16;
    float4 a = *(const float4*)(q), b = *(const float4*)(q + 4), c = *(const float4*)(q + 8), d = *(const float4*)(q + 12);
    float ss = ((a.x + a.y) + (a.z + a.w)) + ((b.x + b.y) + (b.z + b.w)) + ((c.x + c.y) + (c.z + c.w)) + ((d.x + d.y) + (d.z + d.w));
    rstd[mg2] = rsqrtf(ss * (1.f / 1024.f) + 1e-6f);
  }
  const float* xb_ = p.x + (size_t)mt * 256 * 1024 + nt * 256;
  float* ob = p.out + (size_t)mt * 256 * 1024 + nt * 256;
  float4 xpre[2][4]; f32x4 gpre[4];
  epi8<2>(acc,
       [&](int m, int ni, int r, int c) {
         { f32x4 tx = __builtin_nontemporal_load((const f32x4*)(xb_ + (size_t)r * 1024 + c)); xpre[m][ni] = make_float4(tx[0], tx[1], tx[2], tx[3]); }
         if (m == 0) gpre[ni] = *(const f32x4*)(p.norm_post_g + nt * 256 + c);
       },
       [&](int m, int mg2, int ni, int r, int c, f32x4& v) {
         float4 xv = xpre[m][ni]; f32x4 g = gpre[ni]; float rs = rstd[mg2];
         f32x4 ov = {xv.x + v[0] * rs * g[0], xv.y + v[1] * rs * g[1], xv.z + v[2] * rs * g[2], xv.w + v[3] * rs * g[3]};
         __builtin_nontemporal_store(ov, (f32x4*)(ob + (size_t)r * 1024 + c));
       });
}

DEVI int big_tiles_per_wg(int NT, int nb) { return nb == 256 ? (16 * NT + 31) / 32 : (128 * NT + nb - 1) / nb; }
DEVI int big_tile(int i, int NT, int bid, int nb) {
  if (nb == 256) {
    const int x = bid & 7, sl = bid >> 3, l = sl + 32 * i;
    if (l >= 16 * NT) return -1;
    return (x * 16 + l / NT) * NT + (l % NT);
  }
  const int t = bid + i * nb;
  return t < 128 * NT ? t : -1;
}
__global__ void __launch_bounds__(512, 2) mega(P p) {
  __shared__ __attribute__((aligned(16))) char lds_all[131072];
  __shared__ uint4 xb_words;
  cg::grid_group grid = cg::this_grid();
  if (threadIdx.x == 0) xb_words = make_uint4(0u, 0u, 0u, 0u);
  __syncthreads();
  XcdBarrier xb = xcd_barrier_post((unsigned*)(p.ws + O_BAR), (volatile LAS unsigned*)&xb_words);
  if (p.ws == nullptr) grid.sync();
  const int vb = __builtin_amdgcn_readfirstlane(threadIdx.x >> 8);
  char* lds = lds_all + vb * 65536;
  const int nb = gridDim.x, bid = blockIdx.x;
  const int nb2 = nb * 2, bid2 = bid * 2 + vb;
  {
    bool gw = false;
    for (int t0 = bid2; t0 < T0_ALL * (1 + ((DUP >> 0) & 1)); t0 += nb2) {
      const int t = t0 % T0_ALL;
      if (t < T0_ALL - T0_NORM) gw = false;
      if (!gw && t >= T0_ALL - T0_NORM) {
        gw = true;
        __syncthreads();
        const int k4 = tidx() * 4;
        float w[4][8];
#pragma unroll
        for (int e = 0; e < 4; ++e) {
          const float* wrow = p.w_in + (size_t)(k4 + e) * 6152 + 3072;
          float4 a = *(const float4*)(wrow), b = *(const float4*)(wrow + 4);
          w[e][0] = a.x; w[e][1] = a.y; w[e][2] = a.z; w[e][3] = a.w; w[e][4] = b.x; w[e][5] = b.y; w[e][6] = b.z; w[e][7] = b.w;
        }
#pragma unroll
        for (int q = 0; q < 8; ++q) *(float4*)((float*)lds + q * 1024 + k4) = make_float4(w[0][q], w[1][q], w[2][q], w[3][q]);
        __syncthreads();
      }
      phase0(p, lds, t);
    }
  }
  xcd_barrier(xb);
  for (int i = 0; i < big_tiles_per_wg(6, nb); ++i) { const int t = big_tile(i, 6, bid, nb); if (t >= 0) b_phase1(p, lds_all, t); }
  for (int t = bid2; t < 256; t += nb2) gate_pass1(p, t);
  xcd_barrier(xb);
  if (nb2 == 512) {
    if (bid2 < 128) phase2(p, lds, T2_GATE + bid2);
    else if (bid2 < 384) phase2(p, lds, bid2 - 128);
    if (bid2 < 128) { phase2(p, lds, T2_GATE + T2_E + bid2); phase2(p, lds, T2_GATE + T2_E + 128 + bid2); }
    else for (int t = 256 + (bid2 - 128); t < T2_V; t += 384) phase2(p, lds, T2_GATE + T2_E + t);
    phase2(p, lds, T2_GATE + T2_E + T2_V + bid2);
  } else {
    for (int t = bid2; t < T2_ALL; t += nb2) phase2(p, lds, t);
  }
  xcd_barrier(xb);
  if (nb2 == 512) {
    if (bid2 < 32) phase3(p, lds, bid2);
    phase3(p, lds, T3_SCAN + bid2);
    if (bid2 < 32) { for (int i = 0; i < 4; ++i) phase3(p, lds, T3_SCAN + T3_CA + bid2 + 32 * i); }
    else for (int t = 128 + (bid2 - 32); t < T3_QK; t += 480) phase3(p, lds, T3_SCAN + T3_CA + t);
  } else {
    for (int t = bid2; t < T3_ALL; t += nb2) phase3(p, lds, t);
  }
  xcd_barrier(xb);
  for (int task = bid; task < 256; task += nb) cstate64_task(p, lds_all, task, vb);
  if (nb2 == 512 && !((DUP >> 4) & 1)) {
    phase4(p, lds, bid2);
    phase4(p, lds, 1023 - bid2);
  } else {
    for (int t = bid2; t < T4_TOEP * (1 + ((DUP >> 4) & 1)); t += nb2) phase4(p, lds, t % T4_TOEP);
  }
  for (int t = bid2; t < 16; t += nb2) nscan_tile(p, lds, t);
  xcd_barrier(xb);
  for (int i = 0; i < big_tiles_per_wg(2, nb); ++i) { const int t = big_tile(i, 2, bid, nb); if (t >= 0) b_glu(p, lds_all, t); }
  for (int i = 0; i < big_tiles_per_wg(4, nb); ++i) {
    const int t = big_tile(i, 4, bid, nb);
    if (t >= 0) {
      const int mt = t >> 2, hd = t & 3, bh = (mt >> 5) * 4 + hd, c0 = (mt & 31) * 2;
      phase6(p, lds, (bh << 6) | (c0 + vb));
      phase7(p, lds, (bh << 7) | (c0 << 1) | vb);
      phase7(p, lds, (bh << 7) | ((c0 + 1) << 1) | vb);
      b_phase75(p, lds_all, t);
      b_phase8(p, lds_all, t);
    }
  }
  xcd_barrier(xb);
  for (int i = 0; i < big_tiles_per_wg(4, nb); ++i) {
    const int t = big_tile(i, 4, bid, nb);
    if (t >= 0) {
      const int mt = t >> 2, nt = t & 3;
      b_phase85(p, lds_all, mt * 8 + nt);
      b_phase85(p, lds_all, mt * 8 + nt + 4);
      b_phase9(p, lds_all, t);
    }
  }
  xcd_barrier(xb);
  for (int i = 0; i < big_tiles_per_wg(4, nb); ++i) { const int t = big_tile(i, 4, bid, nb); if (t >= 0) b_phase10(p, lds_all, t); }
}

extern "C" void kernel_launch(void* const* d_in, const int* in_sizes, int n_in, void* d_out, int out_size, void* d_ws,
                              size_t ws_size, hipStream_t stream) {
  if (ws_size < O_END) { fprintf(stderr, "workspace too small: %zu < %zu\n", ws_size, (size_t)O_END); return; }
  static int grid_blocks = 0;
  if (!grid_blocks) {
    int dev = 0, cus = 0, per_cu = 0;
    hipGetDevice(&dev);
    hipDeviceGetAttribute(&cus, hipDeviceAttributeMultiprocessorCount, dev);
    hipOccupancyMaxActiveBlocksPerMultiprocessor(&per_cu, mega, 512, 0);
    if (per_cu > 1) per_cu = 1;
    grid_blocks = cus * per_cu;
  }
  P p{};
  const float** pp = (const float**)&p;
  for (int i = 0; i < 26; ++i) pp[i] = (const float*)d_in[i];
  p.out = (float*)d_out;
  p.ws = (char*)d_ws;
  hipMemsetAsync((char*)d_ws + O_BAR, 0, 32768 + 128 * 64, stream);
  void* args[] = {&p};
  hipError_t e = hipLaunchCooperativeKernel((void*)mega, dim3(grid_blocks), dim3(512), args, 0, stream);
  if (e != hipSuccess) fprintf(stderr, "cooperative launch failed: %s (grid %d)\n", hipGetErrorString(e), grid_blocks);
}
```

```cpp
#include <hip/hip_runtime.h>
#include <hip/hip_cooperative_groups.h>
#include <cstdio>
#include <cstdint>
namespace cg = cooperative_groups;

typedef __attribute__((ext_vector_type(8))) short bf16x8;
typedef __attribute__((ext_vector_type(4))) float f32x4;
typedef unsigned short u16;
#define DUP 0
#ifndef PH_MASK
#define PH_MASK 0xFFFF
#endif

#define DEVI __device__ __forceinline__

constexpr int LSEQ = 8192, NTOK = 32768;
constexpr size_t MIB = 1ull << 20;
constexpr size_t O_XN = 0, O_UA = 64 * MIB, O_UB = 128 * MIB, O_CC = 160 * MIB, O_QM = 224 * MIB, O_KM = 288 * MIB,
                 O_KTS = 352 * MIB, O_VT = 416 * MIB, O_MISC = 480 * MIB;
constexpr size_t O_WINT = O_MISC, O_WQT = O_MISC + 12 * MIB, O_WKT = O_WQT + MIB / 2, O_WVT = O_WKT + MIB / 2,
                 O_WAT = O_WVT + MIB / 2, O_WBT = O_WAT + 2 * MIB, O_WGT = O_WBT + MIB, O_WOT = O_WGT + MIB / 2,
                 O_KMAT = O_WOT + 2 * MIB, O_GATES = O_KMAT + MIB, O_ALPHA = O_GATES + MIB, O_RS = O_ALPHA + MIB / 2,
                 O_INTER = O_RS + MIB / 2, O_EMT = O_INTER + MIB / 2, O_KSC = O_EMT + MIB / 2, O_RDEN = O_KSC + MIB / 2,
                 O_NLP = O_RDEN + MIB / 2, O_NPREV = O_NLP + 2 * MIB, O_ACH = O_NPREV + MIB, O_GML = O_ACH + MIB / 16, O_GBL = O_ACH + MIB / 8, O_BAR = O_ACH + MIB / 4, O_END = O_BAR + MIB / 4;
constexpr size_t O_YS5 = O_UA, O_PMAT = O_UA + 32 * MIB, O_CA = O_UA + 32 * MIB, O_XPREV = O_UA + 40 * MIB,
                 O_HSQP = O_UA, O_RSQP = O_UA + 4 * MIB, O_R16 = O_QM,  O_YBIN = O_UB, O_MERGED = O_CC, O_SG = O_QM, O_HBUF = O_KTS;
constexpr size_t OO_WE = 0, OO_E = 8 * MIB;

struct P {
  const float *x, *norm_pre_g, *w_in, *conv_w, *conv_b, *w_q, *w_k, *w_v, *b_i, *b_f, *head_g, *skip_a, *w_a_out,
      *lam_re, *lam_im, *log_dt, *B_re, *B_im, *C_re, *C_im, *D_skip, *w_glu, *b_glu, *w_b_out, *w_o, *norm_post_g;
  float* out;
  char* ws;
};

DEVI int tidx() { int t = threadIdx.x & 255; asm volatile("" : "+v"(t)); return t; }
DEVI int tidx512() { int t = threadIdx.x; asm volatile("" : "+v"(t)); return t; }
typedef __attribute__((ext_vector_type(2))) __bf16 bf16x2_t;
typedef __attribute__((ext_vector_type(2))) float f32x2_t;
DEVI unsigned pk2(float a, float b) {
  f32x2_t f = {a, b};
  return __builtin_bit_cast(unsigned, __builtin_convertvector(f, bf16x2_t));
}
DEVI u16 f2bf(float f) { return (u16)(pk2(f, 0.f) & 0xffffu); }
DEVI float bf2f(u16 h) { return __uint_as_float(((unsigned)h) << 16); }
DEVI uint2 pk4(f32x4 v) { return make_uint2(pk2(v[0], v[1]), pk2(v[2], v[3])); }
DEVI f32x4 unpk4(uint2 u) {
  f32x4 o; o[0] = __uint_as_float(u.x << 16); o[1] = __uint_as_float(u.x & 0xffff0000u);
  o[2] = __uint_as_float(u.y << 16); o[3] = __uint_as_float(u.y & 0xffff0000u); return o;
}
DEVI size_t kb32(size_t m, int k, int K) { return ((m >> 8) * (size_t)(K >> 5) + (k >> 5)) * 8192 + (m & 255) * 32 + (k & 31); }
DEVI float sigm(float x) { return __builtin_amdgcn_rcpf(1.f + __expf(-x)); }
DEVI float siluf(float x) { return x * sigm(x); }
DEVI float geluf(float x) { float t = 0.7978845608028654f * (x + 0.044715f * x * x * x); return 0.5f * x * (1.f + tanhf(t)); }


#define XB_TMO      128
#define XB_XCNT(j)  (256  + 64 * (j))
#define XB_XSUB(j)  (1280 + 64 * (j))
#define XB_XGEN(j)  (2304 + 64 * (j))
#define XB_TOP      3328
#define XB_TOPGEN   3392
#define XCD_BAR_WORDS 3456
#define XB_SPIN_CAP (1u << 20)
#define LAS __attribute__((address_space(3)))
DEVI unsigned xb_ld(unsigned* p) { return __hip_atomic_load(p, __ATOMIC_RELAXED, __HIP_MEMORY_SCOPE_AGENT); }
DEVI unsigned xb_add(unsigned* p, unsigned v) { return __hip_atomic_fetch_add(p, v, __ATOMIC_RELAXED, __HIP_MEMORY_SCOPE_AGENT); }
DEVI unsigned xb_xcc_id() { return (unsigned)__builtin_amdgcn_s_getreg((3 << 11) | 20) & 0xFu; }
#define XB_SPIN(cond, bar) do { unsigned _sp = 0; while (cond) { __builtin_amdgcn_s_sleep(1); \
    if ((++_sp & 255u) == 0u) { if (xb_ld(&(bar)[XB_TMO])) break; if (_sp > XB_SPIN_CAP) { atomicAdd(&(bar)[XB_TMO], 1u); break; } } } } while (0)
struct XcdBarrier { unsigned* bar; unsigned x; volatile LAS unsigned* st; };
DEVI XcdBarrier xcd_barrier_post(unsigned* bar, volatile LAS unsigned* st) {
  XcdBarrier b; b.bar = bar; b.x = xb_xcc_id(); b.st = st;
  if (threadIdx.x == 0) (void)xb_add(&bar[XB_XCNT(b.x)], 1u);
  return b;
}
DEVI void xcd_barrier_complete(unsigned* bar, unsigned x, unsigned& nloc, unsigned& nx) {
  const unsigned G = gridDim.x * gridDim.y * gridDim.z;
  unsigned sum, cnt, mine, sp = 0u;
  for (;;) {
    sum = 0u; cnt = 0u; mine = 0u;
#pragma unroll
    for (unsigned j = 0; j < 16; ++j) { const unsigned c = xb_ld(&bar[XB_XCNT(j)]); sum += c; cnt += (c > 0u) ? 1u : 0u; mine = (j == x) ? c : mine; }
    if (sum == G) break;
    __builtin_amdgcn_s_sleep(1);
    if ((++sp & 255u) == 0u) { if (xb_ld(&bar[XB_TMO])) break; if (sp > XB_SPIN_CAP) { atomicAdd(&bar[XB_TMO], 1u); break; } }
  }
  nloc = mine > 0u ? mine : 1u; nx = cnt > 0u ? cnt : 1u;
}
DEVI void xcd_barrier(const XcdBarrier& b) {
  asm volatile("s_waitcnt vmcnt(0)" ::: "memory");
  __syncthreads();
  if (threadIdx.x == 0) {
    unsigned* bar = b.bar;
    __builtin_amdgcn_s_waitcnt(0);
    unsigned nloc = b.st[0], nx = b.st[1];
    if (nloc == 0u) { xcd_barrier_complete(bar, b.x, nloc, nx); b.st[0] = nloc; b.st[1] = nx; }
    const unsigned old = xb_add(&bar[XB_XSUB(b.x)], 1u);
    const unsigned gen = old / nloc;
    if (old + 1u == (gen + 1u) * nloc) {
      __builtin_amdgcn_fence(__ATOMIC_RELEASE, "agent");
      asm volatile("s_waitcnt vmcnt(0)" ::: "memory");
      const unsigned og = xb_add(&bar[XB_TOP], 1u);
      const unsigned tg = og / nx;
      if (og + 1u == (tg + 1u) * nx) xb_add(&bar[XB_TOPGEN], 1u);
      else XB_SPIN(xb_ld(&bar[XB_TOPGEN]) == tg, bar);
      __builtin_amdgcn_fence(__ATOMIC_ACQUIRE, "agent");
      xb_add(&bar[XB_XGEN(b.x)], 1u);
      asm volatile("s_waitcnt vmcnt(0)" ::: "memory");
    } else {
      XB_SPIN(xb_ld(&bar[XB_XGEN(b.x)]) == gen, bar);
      __builtin_amdgcn_fence(__ATOMIC_ACQUIRE, "agent");
      asm volatile("s_waitcnt vmcnt(0)" ::: "memory");
    }
  }
  __syncthreads();
}

DEVI void glds16(const void* g, char* l) {
  unsigned la = (unsigned)(unsigned long long)(LAS char*)l;
  unsigned base = __builtin_amdgcn_readfirstlane(la);
  asm volatile("s_mov_b32 m0, %0\n\ts_nop 0\n\tglobal_load_lds_dwordx4 %1, off" ::"s"(base), "v"(g) : "memory", "m0");
}
template <bool SWAP, class AL, class BL>
DEVI void gemm_acc(f32x4 (&acc)[4][4], char* lds, AL al, BL bl, int nk64) {
  const int nk = nk64 * 2;
  const int tid = tidx(), lane = tid & 63, wid = tid >> 6, wr = wid >> 1, wc = wid & 1, fr = lane & 15, fq = lane >> 4;
  const int sb = (tid & 63) * 16;
  const int swz = sb ^ (((sb >> 9) & 1) << 5);
  const int R0 = (tid >> 6) * 16 + (swz >> 6);
  const int C0 = (swz & 63) >> 1;
  const int lo = ((fr * 64 + fq * 16) ^ ((fr >> 3) << 5));
  const int wofs = tid * 16;
  asm volatile("s_waitcnt vmcnt(0)" ::: "memory");
  __syncthreads();
#pragma unroll
  for (int s0 = 0; s0 < 3; ++s0) {
    if (s0 < nk) {
      char* st = lds + s0 * 16384;
      const int kc = s0 * 32 + C0;
      glds16(al(R0, kc), st + wofs); glds16(al(R0 + 64, kc), st + wofs + 4096);
      glds16(bl(R0, kc), st + 8192 + wofs); glds16(bl(R0 + 64, kc), st + 8192 + wofs + 4096);
    }
  }
#pragma unroll 1
  for (int ks = 0; ks < nk; ++ks) {
    if (ks + 2 < nk) asm volatile("s_waitcnt vmcnt(8)" ::: "memory");
    else if (ks + 1 < nk) asm volatile("s_waitcnt vmcnt(4)" ::: "memory");
    else asm volatile("s_waitcnt vmcnt(0)" ::: "memory");
    __syncthreads();
    if (ks + 3 < nk) {
      char* st = lds + ((ks + 3) & 3) * 16384;
      const int kc = (ks + 3) * 32 + C0;
      glds16(al(R0, kc), st + wofs); glds16(al(R0 + 64, kc), st + wofs + 4096);
      glds16(bl(R0, kc), st + 8192 + wofs); glds16(bl(R0 + 64, kc), st + 8192 + wofs + 4096);
    }
    __builtin_amdgcn_sched_barrier(0);
    const char* cur = lds + (ks & 3) * 16384;
    bf16x8 af[4], bfr[4];
#pragma unroll
    for (int mi = 0; mi < 4; ++mi) af[mi] = *(const bf16x8*)(cur + (wr * 4 + mi) * 1024 + lo);
#pragma unroll
    for (int ni = 0; ni < 4; ++ni) bfr[ni] = *(const bf16x8*)(cur + 8192 + (wc * 4 + ni) * 1024 + lo);
#pragma unroll
    for (int mi = 0; mi < 4; ++mi)
#pragma unroll
      for (int ni = 0; ni < 4; ++ni) {
        if (SWAP) acc[mi][ni] = __builtin_amdgcn_mfma_f32_16x16x32_bf16(bfr[ni], af[mi], acc[mi][ni], 0, 0, 0);
        else acc[mi][ni] = __builtin_amdgcn_mfma_f32_16x16x32_bf16(af[mi], bfr[ni], acc[mi][ni], 0, 0, 0);
      }
  }
  __syncthreads();
}
template <bool SWAP>
DEVI void gemm_plain(f32x4 (&acc)[4][4], char* lds, const u16* A, size_t lda, const u16* B, size_t ldb, int nk) {
  gemm_acc<SWAP>(acc, lds, [=](int r, int k) { return (const void*)(A + (size_t)r * lda + k); },
                 [=](int n, int k) { return (const void*)(B + (size_t)n * ldb + k); }, nk);
}
DEVI void zero_acc(f32x4 (&acc)[4][4]) {
#pragma unroll
  for (int i = 0; i < 4; ++i)
#pragma unroll
    for (int j = 0; j < 4; ++j) acc[i][j] = f32x4{0.f, 0.f, 0.f, 0.f};
}
template <bool SWAP, class F>
DEVI void for_acc(f32x4 (&acc)[4][4], F f) {
  const int tid = tidx(), lane = tid & 63, wid = tid >> 6, wr = wid >> 1, wc = wid & 1, fr = lane & 15, fq = lane >> 4;
#pragma unroll
  for (int mi = 0; mi < 4; ++mi)
#pragma unroll
    for (int ni = 0; ni < 4; ++ni) {
      int r, c;
      if (SWAP) { r = wr * 64 + mi * 16 + fr; c = wc * 64 + ni * 16 + fq * 4; }
      else { r = wr * 64 + mi * 16 + fq * 4; c = wc * 64 + ni * 16 + fr; }
      f(mi, ni, r, c, acc[mi][ni]);
      __builtin_amdgcn_sched_barrier(0);
    }
}
template <bool SWAP, class F>
DEVI void for_idx(F f) {
  const int tid = tidx(), lane = tid & 63, wid = tid >> 6, wr = wid >> 1, wc = wid & 1, fr = lane & 15, fq = lane >> 4;
#pragma unroll
  for (int mi = 0; mi < 4; ++mi)
#pragma unroll
    for (int ni = 0; ni < 4; ++ni) {
      int r, c;
      if (SWAP) { r = wr * 64 + mi * 16 + fr; c = wc * 64 + ni * 16 + fq * 4; }
      else { r = wr * 64 + mi * 16 + fq * 4; c = wc * 64 + ni * 16 + fr; }
      f(mi, ni, r, c);
    }
}
DEVI float red_fq(float v) { v += __shfl_xor(v, 16); v += __shfl_xor(v, 32); return v; }


DEVI void wait_vm_stage(int rem) {
  if (rem >= 2) asm volatile("s_waitcnt vmcnt(8)" ::: "memory");
  else if (rem == 1) asm volatile("s_waitcnt vmcnt(4)" ::: "memory");
  else asm volatile("s_waitcnt vmcnt(0)" ::: "memory");
}
template <class AL, class BL>
DEVI void gemm8_acc(f32x4 (&acc)[8][4], char* lds, AL al, BL bl, int nk) {
  const int tid = tidx512(), lane = tid & 63, wid = tid >> 6, wr = wid >> 2, wc = wid & 3, fr = lane & 15, fq = lane >> 4;
  const int grp = __builtin_amdgcn_readfirstlane(wid >> 2);
  const int sb = (tid & 63) * 16;
  const int swz = sb ^ (((sb >> 9) & 1) << 5);
  const int R0 = (tid >> 6) * 16 + (swz >> 6);
  const int C0 = (swz & 63) >> 1;
  const int lo = ((fr * 64 + fq * 16) ^ ((fr >> 3) << 5));
  const int wofs = tid * 16;
  asm volatile("s_waitcnt vmcnt(0)" ::: "memory");
  __syncthreads();
#pragma unroll
  for (int s0 = 0; s0 < 3; ++s0) {
    if (s0 < nk) {
      char* st = lds + s0 * 32768;
      const int kc = s0 * 32 + C0;
      glds16(al(R0, kc), st + wofs); glds16(al(R0 + 128, kc), st + wofs + 8192);
      glds16(bl(R0, kc), st + 16384 + wofs); glds16(bl(R0 + 128, kc), st + 16384 + wofs + 8192);
    }
  }
  wait_vm_stage(nk - 1);
  __builtin_amdgcn_s_barrier();
  if (grp == 1) __builtin_amdgcn_s_barrier();
#pragma unroll 1
  for (int ks = 0; ks < nk; ++ks) {
    if (ks + 3 < nk) {
      char* st = lds + ((ks + 3) & 3) * 32768;
      const int kc = (ks + 3) * 32 + C0;
      glds16(al(R0, kc), st + wofs); glds16(al(R0 + 128, kc), st + wofs + 8192);
      glds16(bl(R0, kc), st + 16384 + wofs); glds16(bl(R0 + 128, kc), st + 16384 + wofs + 8192);
    }
    __builtin_amdgcn_sched_barrier(0);
    const char* cur = lds + (ks & 3) * 32768;
    bf16x8 af[8], bfr[4];
#pragma unroll
    for (int mi = 0; mi < 8; ++mi) af[mi] = *(const bf16x8*)(cur + (wr * 8 + mi) * 1024 + lo);
#pragma unroll
    for (int ni = 0; ni < 4; ++ni) bfr[ni] = *(const bf16x8*)(cur + 16384 + (wc * 4 + ni) * 1024 + lo);
    asm volatile("s_waitcnt lgkmcnt(0)" ::: "memory");
    if (grp == 1) wait_vm_stage(nk - 2 - ks);
    __builtin_amdgcn_sched_barrier(0);
    __builtin_amdgcn_s_barrier();
    __builtin_amdgcn_sched_barrier(0);
    __builtin_amdgcn_s_setprio(1);
#pragma unroll
    for (int mi = 0; mi < 8; ++mi)
#pragma unroll
      for (int ni = 0; ni < 4; ++ni) acc[mi][ni] = __builtin_amdgcn_mfma_f32_16x16x32_bf16(bfr[ni], af[mi], acc[mi][ni], 0, 0, 0);
    __builtin_amdgcn_s_setprio(0);
    if (grp == 0) wait_vm_stage(nk - 2 - ks);
    __builtin_amdgcn_sched_barrier(0);
    __builtin_amdgcn_s_barrier();
    __builtin_amdgcn_sched_barrier(0);
  }
  if (grp == 0) __builtin_amdgcn_s_barrier();
  __syncthreads();
}
DEVI void gemm8_plain(f32x4 (&acc)[8][4], char* lds, const u16* A, size_t lda, const u16* B, size_t ldb, int nk) {
  gemm8_acc(acc, lds, [=](int r, int k) { return (const void*)(A + (size_t)r * lda + k); },
            [=](int n, int k) { return (const void*)(B + (size_t)n * ldb + k); }, nk);
}
DEVI void glds16s(const u16* sbase, unsigned voff, char* l) {
  unsigned la = (unsigned)(unsigned long long)(LAS char*)l;
  unsigned base = __builtin_amdgcn_readfirstlane(la);
  asm volatile("s_mov_b32 m0, %0\n\ts_nop 0\n\tglobal_load_lds_dwordx4 %1, %2" ::"s"(base), "v"(voff), "s"(sbase) : "memory", "m0");
}
DEVI void gemm8_kb(f32x4 (&acc)[8][4], char* lds, const u16* At, const u16* Bt, int nk) {
  const int tid = tidx512(), lane = tid & 63, wid = tid >> 6, wr = wid >> 2, wc = wid & 3, fr = lane & 15, fq = lane >> 4;
  const int grp = __builtin_amdgcn_readfirstlane(wid >> 2);
  const int sb = (tid & 63) * 16;
  const int swz = sb ^ (((sb >> 9) & 1) << 5);
  const unsigned voff = (unsigned)((tid >> 6) * 1024 + swz);
  const int lo = ((fr * 64 + fq * 16) ^ ((fr >> 3) << 5));
  const int wofs = tid * 16;
  asm volatile("s_waitcnt vmcnt(0)" ::: "memory");
  __syncthreads();
#pragma unroll
  for (int s0 = 0; s0 < 3; ++s0) {
    if (s0 < nk) {
      char* st = lds + s0 * 32768;
      glds16s(At + (size_t)s0 * 8192, voff, st + wofs); glds16s(At + (size_t)s0 * 8192 + 4096, voff, st + wofs + 8192);
      glds16s(Bt + (size_t)s0 * 8192, voff, st + 16384 + wofs); glds16s(Bt + (size_t)s0 * 8192 + 4096, voff, st + 16384 + wofs + 8192);
    }
  }
  wait_vm_stage(nk - 1);
  __builtin_amdgcn_s_barrier();
  if (grp == 1) __builtin_amdgcn_s_barrier();
#pragma unroll 1
  for (int ks = 0; ks < nk; ++ks) {
    const char* cur = lds + (ks & 3) * 32768;
    bf16x8 af[8], bfr[4];
#pragma unroll
    for (int mi = 0; mi < 8; ++mi) af[mi] = *(const bf16x8*)(cur + (wr * 8 + mi) * 1024 + lo);
#pragma unroll
    for (int ni = 0; ni < 4; ++ni) bfr[ni] = *(const bf16x8*)(cur + 16384 + (wc * 4 + ni) * 1024 + lo);
    __builtin_amdgcn_sched_barrier(0);
    if (ks + 3 < nk) {
      char* st = lds + ((ks + 3) & 3) * 32768;
      const u16* as = At + (size_t)(ks + 3) * 8192;
      const u16* bs = Bt + (size_t)(ks + 3) * 8192;
      glds16s(as, voff, st + wofs); glds16s(as + 4096, voff, st + wofs + 8192);
      glds16s(bs, voff, st + 16384 + wofs); glds16s(bs + 4096, voff, st + 16384 + wofs + 8192);
    }
    asm volatile("s_waitcnt lgkmcnt(0)" ::: "memory");
    if (grp == 1) wait_vm_stage(nk - 2 - ks);
    __builtin_amdgcn_sched_barrier(0);
    __builtin_amdgcn_s_barrier();
    __builtin_amdgcn_sched_barrier(0);
    __builtin_amdgcn_s_setprio(1);
#pragma unroll
    for (int mi = 0; mi < 8; ++mi)
#pragma unroll
      for (int ni = 0; ni < 4; ++ni) acc[mi][ni] = __builtin_amdgcn_mfma_f32_16x16x32_bf16(bfr[ni], af[mi], acc[mi][ni], 0, 0, 0);
    __builtin_amdgcn_s_setprio(0);
    if (grp == 0) wait_vm_stage(nk - 2 - ks);
    __builtin_amdgcn_sched_barrier(0);
    __builtin_amdgcn_s_barrier();
    __builtin_amdgcn_sched_barrier(0);
  }
  if (grp == 0) __builtin_amdgcn_s_barrier();
  __syncthreads();
}
DEVI void zero_acc8(f32x4 (&acc)[8][4]) {
#pragma unroll
  for (int i = 0; i < 8; ++i)
#pragma unroll
    for (int j = 0; j < 4; ++j) acc[i][j] = f32x4{0.f, 0.f, 0.f, 0.f};
}
template <int MH = 4, bool SB = true, class PRE, class MAIN>
DEVI void epi8(f32x4 (&acc)[8][4], PRE pre, MAIN mainf) {
  const int tid = tidx512(), lane = tid & 63, wid = tid >> 6, wr = wid >> 2, wc = wid & 3, fr = lane & 15, fq = lane >> 4;
#pragma unroll
  for (int h = 0; h < 8 / MH; ++h) {
#pragma unroll
    for (int m = 0; m < MH; ++m)
#pragma unroll
      for (int ni = 0; ni < 4; ++ni) pre(m, ni, wr * 128 + (h * MH + m) * 16 + fr, wc * 64 + ni * 16 + fq * 4);
    if (SB) __builtin_amdgcn_sched_barrier(0);
#pragma unroll
    for (int m = 0; m < MH; ++m)
#pragma unroll
      for (int ni = 0; ni < 4; ++ni) {
        mainf(m, h * MH + m, ni, wr * 128 + (h * MH + m) * 16 + fr, wc * 64 + ni * 16 + fq * 4, acc[h * MH + m][ni]);
        if (SB) __builtin_amdgcn_sched_barrier(0);
      }
  }
}

struct S5gp { float lrdt, lidt, qre, qim; };
DEVI void sincos_rr(float ang, float& s, float& c) {
  float k = rintf(ang * 0.15915494309189535f);
  float r = fmaf(-k, 6.2831855f, ang);
  r = fmaf(-k, -1.7484556e-7f, r);
  s = __sinf(r); c = __cosf(r);
}
DEVI S5gp s5_gp(const P& p, int g, int pp) {
  float dt = expf(p.log_dt[g]);
  float lr = p.lam_re[g * 64 + pp], li = p.lam_im[g * 64 + pp];
  float mag = expf(lr * dt), s, c;
  sincos_rr(li * dt, s, c);
  float are = mag * c, aim = mag * s, den = lr * lr + li * li, nr = are - 1.f;
  S5gp r; r.qre = (nr * lr + aim * li) / den; r.qim = (aim * lr - nr * li) / den; r.lrdt = lr * dt; r.lidt = li * dt;
  return r;
}
DEVI void s5_pow(const S5gp& s, float n, float& er, float& ei) {
  float mag = expf(s.lrdt * n), sn, cs;
  sincos_rr(s.lidt * n, sn, cs);
  er = mag * cs; ei = mag * sn;
}

DEVI void transpose_tile(const float* src, size_t ld_src, int srccol0, int k0, u16* dst, size_t ld_dst, int n0, float* tile, bool kb = false) {
  const int tid = tidx(), tx = tid & 15, ty = tid >> 4;
  __syncthreads();
#pragma unroll
  for (int rr = 0; rr < 4; ++rr) {
    int k = ty + 16 * rr;
    float4 v = *(const float4*)(src + (size_t)(k0 + k) * ld_src + srccol0 + tx * 4);
    tile[k * 65 + tx * 4 + 0] = v.x; tile[k * 65 + tx * 4 + 1] = v.y; tile[k * 65 + tx * 4 + 2] = v.z; tile[k * 65 + tx * 4 + 3] = v.w;
  }
  __syncthreads();
  const int kx = tid & 7, ny = tid >> 3;
#pragma unroll
  for (int rr = 0; rr < 2; ++rr) {
    int n = ny + 32 * rr;
    float f[8];
#pragma unroll
    for (int e = 0; e < 8; ++e) f[e] = tile[(kx * 8 + e) * 65 + n];
    uint4 o = make_uint4(pk2(f[0], f[1]), pk2(f[2], f[3]), pk2(f[4], f[5]), pk2(f[6], f[7]));
    if (kb) *(uint4*)(dst + kb32(n0 + n, k0 + kx * 8, (int)ld_dst)) = o;
    else *(uint4*)(dst + (size_t)(n0 + n) * ld_dst + k0 + kx * 8) = o;
  }
}

constexpr int T0_WIN = 1536, T0_QKV = 192, T0_WA = 256, T0_WB = 128, T0_WG = 64, T0_WO = 256;
constexpr int T0_TR = T0_WIN + T0_QKV + T0_WA + T0_WB + T0_WG + T0_WO;
constexpr int T0_KMAT = 512, T0_WE = 512, T0_NORM = 2048;
constexpr int T0_ALL = T0_TR + T0_KMAT + T0_WE + T0_NORM;

DEVI void phase0(const P& p, char* lds, int t) {
  const int tid = tidx();
  char* ws = p.ws;
  if (t < T0_TR) {
    float* tile = (float*)lds;
    if (t < T0_WIN) {
      int kt = t / 96, nt = t % 96, n0 = nt * 64;
      transpose_tile(p.w_in, 6152, n0 + (n0 >= 3072 ? 8 : 0), kt * 64, (u16*)(ws + O_WINT), 1024, n0, tile, true);
      return;
    }
    t -= T0_WIN;
    if (t < T0_QKV) {
      int which = t / 64, r = t % 64, h = r / 16, kt = (r % 16) / 4, nt = r % 4;
      const float* src = (which == 0 ? p.w_q : which == 1 ? p.w_k : p.w_v) + (size_t)h * 65536;
      u16* dst = (u16*)(ws + (which == 0 ? O_WQT : which == 1 ? O_WKT : O_WVT)) + (size_t)h * 65536;
      transpose_tile(src, 256, nt * 64, kt * 64, dst, 256, nt * 64, tile);
      return;
    }
    t -= T0_QKV;
    if (t < T0_WA) { transpose_tile(p.w_a_out, 1024, (t % 16) * 64, (t / 16) * 64, (u16*)(ws + O_WAT), 1024, (t % 16) * 64, tile, true); return; }
    t -= T0_WA;
    if (t < T0_WB) { transpose_tile(p.w_b_out, 1024, (t % 16) * 64, (t / 16) * 64, (u16*)(ws + O_WBT), 512, (t % 16) * 64, tile, true); return; }
    t -= T0_WB;
    if (t < T0_WG) { transpose_tile(p.w_glu, 512, (t % 8) * 64, (t / 8) * 64, (u16*)(ws + O_WGT), 512, (t % 8) * 64, tile, true); return; }
    t -= T0_WG;
    transpose_tile(p.w_o, 1024, (t % 16) * 64, (t / 16) * 64, (u16*)(ws + O_WOT), 1024, (t % 16) * 64, tile, true);
    return;
  }
  t -= T0_TR;
  if (t < T0_KMAT) {
    const int g = t >> 4, lag0 = (t & 15) * 4;
    float* Wre = (float*)lds;
    float* Wim = Wre + 4 * 16 * 68;
    __syncthreads();
    {
      const int ll = tid >> 6, pp = tid & 63;
      S5gp sg5 = s5_gp(p, g, pp);
      float er, ei; s5_pow(sg5, (float)(lag0 + ll), er, ei);
      const float* Br = p.B_re + (size_t)(g * 64 + pp) * 16;
      const float* Bi = p.B_im + (size_t)(g * 64 + pp) * 16;
#pragma unroll
      for (int m = 0; m < 16; ++m) {
        float br = Br[m], bi = Bi[m];
        float bbr = sg5.qre * br - sg5.qim * bi, bbi = sg5.qre * bi + sg5.qim * br;
        Wre[(ll * 16 + m) * 68 + pp] = er * bbr - ei * bbi;
        Wim[(ll * 16 + m) * 68 + pp] = er * bbi + ei * bbr;
      }
    }
    __syncthreads();
    {
      const int ll = tid >> 6, n = (tid >> 2) & 15, mq = tid & 3;
      const float* cr = p.C_re + (size_t)(g * 16 + n) * 64;
      const float* ci = p.C_im + (size_t)(g * 16 + n) * 64;
      float acc[4] = {0.f, 0.f, 0.f, 0.f};
#pragma unroll 4
      for (int p4 = 0; p4 < 16; ++p4) {
        float4 c_r = *(const float4*)(cr + p4 * 4), c_i = *(const float4*)(ci + p4 * 4);
#pragma unroll
        for (int e = 0; e < 4; ++e) {
          float4 wr4 = *(const float4*)(Wre + (ll * 16 + mq * 4 + e) * 68 + p4 * 4);
          float4 wi4 = *(const float4*)(Wim + (ll * 16 + mq * 4 + e) * 68 + p4 * 4);
          acc[e] += c_r.x * wr4.x - c_i.x * wi4.x + c_r.y * wr4.y - c_i.y * wi4.y + c_r.z * wr4.z - c_i.z * wi4.z + c_r.w * wr4.w - c_i.w * wi4.w;
        }
      }
      *(uint2*)((u16*)(ws + O_KMAT) + ((size_t)(g * 64 + lag0 + ll) * 16 + n) * 16 + mq * 4) = make_uint2(pk2(acc[0], acc[1]), pk2(acc[2], acc[3]));
    }
    return;
  }
  t -= T0_KMAT;
  if (t < T0_WE) {
    int gid = t * 256 + tid, i = gid & 63, pp = (gid >> 6) & 63, g = gid >> 12;
    S5gp s = s5_gp(p, g, pp);
    float er, ei; s5_pow(s, (float)(63 - i), er, ei);
    const float* Br = p.B_re + (size_t)(g * 64 + pp) * 16;
    const float* Bi = p.B_im + (size_t)(g * 64 + pp) * 16;
    float vr[16], vi[16];
#pragma unroll
    for (int m = 0; m < 16; ++m) {
      float br = Br[m], bi = Bi[m];
      float bbr = s.qre * br - s.qim * bi, bbi = s.qre * bi + s.qim * br;
      vr[m] = er * bbr - ei * bbi; vi[m] = er * bbi + ei * bbr;
    }
    u16* we = (u16*)((char*)p.out + OO_WE);
    uint4* d0 = (uint4*)(we + (size_t)(g * 128 + pp) * 1024 + i * 16);
    uint4* d1 = (uint4*)(we + (size_t)(g * 128 + 64 + pp) * 1024 + i * 16);
    d0[0] = make_uint4(pk2(vr[0], vr[1]), pk2(vr[2], vr[3]), pk2(vr[4], vr[5]), pk2(vr[6], vr[7]));
    d0[1] = make_uint4(pk2(vr[8], vr[9]), pk2(vr[10], vr[11]), pk2(vr[12], vr[13]), pk2(vr[14], vr[15]));
    d1[0] = make_uint4(pk2(vi[0], vi[1]), pk2(vi[2], vi[3]), pk2(vi[4], vi[5]), pk2(vi[6], vi[7]));
    d1[1] = make_uint4(pk2(vi[8], vi[9]), pk2(vi[10], vi[11]), pk2(vi[12], vi[13]), pk2(vi[14], vi[15]));
    return;
  }
  t -= T0_WE;
  {
    const int lane = tid & 63;
    float4 vv[4][4];
#pragma unroll
    for (int q = 0; q < 4; ++q) {
      const float* xr = p.x + (size_t)(t * 16 + q * 4 + (tid >> 6)) * 1024;
#pragma unroll
      for (int j = 0; j < 4; ++j) { f32x4 tx = __builtin_nontemporal_load((const f32x4*)(xr + j * 256 + lane * 4)); vv[q][j] = make_float4(tx[0], tx[1], tx[2], tx[3]); }
    }
    float4 gg[4];
#pragma unroll
    for (int j = 0; j < 4; ++j) gg[j] = *(const float4*)(p.norm_pre_g + j * 256 + lane * 4);
    u16* xn = (u16*)(ws + O_XN);
#pragma unroll
    for (int q = 0; q < 4; ++q) {
      const int row = t * 16 + q * 4 + (tid >> 6);
      float ss = 0.f;
#pragma unroll
      for (int j = 0; j < 4; ++j) ss += vv[q][j].x * vv[q][j].x + vv[q][j].y * vv[q][j].y + vv[q][j].z * vv[q][j].z + vv[q][j].w * vv[q][j].w;
#pragma unroll
      for (int o = 32; o >= 1; o >>= 1) ss += __shfl_xor(ss, o);
      float rstd = rsqrtf(ss * (1.f / 1024.f) + 1e-6f);
      float gp[8];
#pragma unroll
      for (int qq = 0; qq < 8; ++qq) gp[qq] = 0.f;
#pragma unroll
      for (int j = 0; j < 4; ++j) {
        int k = j * 256 + lane * 4;
        float4 g = gg[j];
        float e[4] = {vv[q][j].x * rstd * g.x, vv[q][j].y * rstd * g.y, vv[q][j].z * rstd * g.z, vv[q][j].w * rstd * g.w};
        *(uint2*)(xn + kb32(row, k, 1024)) = make_uint2(pk2(e[0], e[1]), pk2(e[2], e[3]));
#pragma unroll
        for (int qq = 0; qq < 8; ++qq) {
          float4 w = *(const float4*)((const float*)lds + qq * 1024 + k);
          gp[qq] += e[0] * w.x + e[1] * w.y + e[2] * w.z + e[3] * w.w;
        }
      }
#pragma unroll
      for (int qq = 0; qq < 8; ++qq) {
#pragma unroll
        for (int o = 32; o >= 1; o >>= 1) gp[qq] += __shfl_xor(gp[qq], o);
      }
      if (lane == 0) {
        float* gt = (float*)(ws + O_GATES) + (size_t)row * 8;
        *(float4*)(gt) = make_float4(gp[0], gp[1], gp[2], gp[3]);
        *(float4*)(gt + 4) = make_float4(gp[4], gp[5], gp[6], gp[7]);
      }
    }
  }
}

DEVI void phase1(const P& p, char* lds, int t) {
  char* ws = p.ws;
  int mt = t / 12, nt = t % 12;
  const u16* A = (const u16*)(ws + O_XN) + (size_t)mt * 128 * 1024;
  int wrow = nt < 8 ? nt * 128 : 3072 + (nt - 8) * 128;
  const u16* B = (const u16*)(ws + O_WINT) + (size_t)wrow * 1024;
  f32x4 acc[4][4]; zero_acc(acc);
  gemm_plain<true>(acc, lds, A, 1024, B, 1024, 16);
  u16* dst; size_t ld;
  if (nt < 8) { dst = (u16*)(ws + O_UA) + (size_t)mt * 128 * 1024 + nt * 128; ld = 1024; }
  else { dst = (u16*)(ws + O_UB) + (size_t)mt * 128 * 512 + (nt - 8) * 128; ld = 512; }
  for_acc<true>(acc, [&](int, int, int r, int c, f32x4 v) { *(uint2*)(dst + (size_t)r * ld + c) = pk4(v); });
}

constexpr int T2_GATE = 256, T2_E = 128, T2_V = 2048, T2_CONV = 512, T2_ALL = T2_GATE + T2_E + T2_V + T2_CONV;
DEVI float wave_incl_sum(float v, int lane) {
#pragma unroll
  for (int o = 1; o < 64; o <<= 1) { float u = __shfl_up(v, o); if (lane >= o) v += u; }
  return v;
}
DEVI float wave_incl_max(float v, int lane) {
#pragma unroll
  for (int o = 1; o < 64; o <<= 1) { float u = __shfl_up(v, o); if (lane >= o) v = fmaxf(v, u); }
  return v;
}

DEVI void gate_pass1(const P& p, int t) {
  const int tid = tidx(), lane = tid & 63, wid = tid >> 6;
  char* ws = p.ws;
  const int bh = t >> 4, c = (t & 15) * 4 + wid, b = bh >> 2, h = bh & 3;
  const float* gates = (const float*)(ws + O_GATES);
  float* A_ = (float*)(ws + O_ALPHA) + (size_t)bh * LSEQ;
  float* R_ = (float*)(ws + O_RS) + (size_t)bh * LSEQ;
  float* I_ = (float*)(ws + O_INTER) + (size_t)bh * LSEQ;
  const float bi = p.b_i[h], bf = p.b_f[h];
  const float NINF = -__builtin_huge_valf();
  int tp = c * 128 + 2 * lane;
  size_t tok = (size_t)b * LSEQ + tp;
  float ig0 = gates[tok * 8 + h] + bi, ig1 = gates[(tok + 1) * 8 + h] + bi;
  float f0 = gates[tok * 8 + 4 + h] + bf, f1 = gates[(tok + 1) * 8 + 4 + h] + bf;
  float lf0 = fminf(f0, 0.f) - log1pf(expf(-fabsf(f0)));
  float lf1 = fminf(f1, 0.f) - log1pf(expf(-fabsf(f1)));
  float s1 = lf0 + lf1;
  float incl = wave_incl_sum(s1, lane);
  float excl = incl - s1;
  float b0 = excl + lf0, b1 = excl + s1;
  float blast = __shfl(incl, 63);
  float r0 = ig0 - b0, r1 = ig1 - b1;
  float pm = fmaxf(r0, r1);
  float im = wave_incl_max(pm, lane);
  float em = __shfl_up(im, 1); if (lane == 0) em = NINF;
  float rm0 = fmaxf(em, r0), rm1 = fmaxf(em, pm);
  float mall = __shfl(im, 63);
  *(float2*)(A_ + tp) = make_float2(b0, b1);
  *(float2*)(R_ + tp) = make_float2(r0, r1);
  *(float2*)(I_ + tp) = make_float2(rm0, rm1);
  if (lane == 0) { ((float*)(ws + O_GML))[bh * 64 + c] = blast + mall; ((float*)(ws + O_GBL))[bh * 64 + c] = blast; }
}

DEVI void phase2(const P& p, char* lds, int t) {
  const int tid = tidx(), lane = tid & 63, wid = tid >> 6;
  char* ws = p.ws;
  if (t < T2_GATE) {
    const int bh = t >> 4, c = (t & 15) * 4 + wid;
    const float* gml = (const float*)(ws + O_GML) + bh * 64;
    const float* gbl = (const float*)(ws + O_GBL) + bh * 64;
    float* A_ = (float*)(ws + O_ALPHA) + (size_t)bh * LSEQ;
    float* R_ = (float*)(ws + O_RS) + (size_t)bh * LSEQ;
    float* I_ = (float*)(ws + O_INTER) + (size_t)bh * LSEQ;
    float* E_ = (float*)(ws + O_EMT) + (size_t)bh * LSEQ;
    float* K_ = (float*)(ws + O_KSC) + (size_t)bh * LSEQ;
    const float NINF = -__builtin_huge_valf();
    float a = gbl[lane], bsc = gml[lane];
    float A = a, B = bsc;
#pragma unroll
    for (int o = 1; o < 64; o <<= 1) {
      float Ap = __shfl_up(A, o), Bp = __shfl_up(B, o);
      if (lane >= o) { B = fmaxf(Bp + A, B); A = Ap + A; }
    }
    float Bprev = __shfl_up(B, 1); if (lane == 0) Bprev = NINF;
    const float mp = __shfl(Bprev, c), mn = __shfl(B, c), bl = __shfl(a, c);
    if (lane == 0) ((float*)(ws + O_ACH))[bh * 64 + c] = (mp == NINF) ? 0.f : expf(bl + mp - mn);
    int tp = c * 128 + 2 * lane;
    float2 bb = *(float2*)(A_ + tp), rr = *(float2*)(R_ + tp), rm = *(float2*)(I_ + tp);
    float mt0 = bb.x + fmaxf(mp, rm.x), mt1 = bb.y + fmaxf(mp, rm.y);
    float a0 = bb.x - mt0, a1 = bb.y - mt1;
    float i0 = (mp == NINF) ? 0.f : expf(a0 + mp), i1 = (mp == NINF) ? 0.f : expf(a1 + mp);
    *(float2*)(A_ + tp) = make_float2(a0, a1);
    *(float2*)(I_ + tp) = make_float2(i0, i1);
    *(float2*)(E_ + tp) = make_float2(expf(-mt0), expf(-mt1));
    *(float2*)(K_ + tp) = make_float2(expf(bl + rr.x - mn), expf(bl + rr.y - mn));
    return;
  }
  t -= T2_GATE;
  if (t < T2_E) {
    int g = t >> 2, mt = t & 3;
    const u16* ub = (const u16*)(ws + O_UB) + (size_t)g * 524288 + (size_t)mt * 128 * 1024;
    const u16* we = (const u16*)((char*)p.out + OO_WE) + (size_t)g * 128 * 1024;
    f32x4 acc[4][4]; zero_acc(acc);
    gemm_plain<true>(acc, lds, ub, 1024, we, 1024, 16);
    float* E = (float*)((char*)p.out + OO_E);
    for_acc<true>(acc, [&](int, int, int r, int c, f32x4 v) {
      *(f32x4*)(E + ((size_t)(mt * 128 + r) * 32 + g) * 128 + c) = v;
    });
    return;
  }
  t -= T2_E;
  if (t < T2_V) {
    int mt = t >> 3, h = (t >> 1) & 3, nt = t & 1;
    const u16* A = (const u16*)(ws + O_UA) + (size_t)mt * 128 * 1024 + h * 256;
    const u16* B = (const u16*)(ws + O_WVT) + (size_t)(h * 256 + nt * 128) * 256;
    f32x4 acc[4][4]; zero_acc(acc);
    gemm_plain<false>(acc, lds, A, 1024, B, 256, 4);
    int bh = (mt >> 6) * 4 + h, tp0 = (mt & 63) * 128;
    u16* vt = (u16*)(ws + O_VT) + (size_t)(bh * 64 + (mt & 63)) * 32768 + (nt * 128) * 32;
    for_acc<false>(acc, [&](int, int, int r, int c, f32x4 v) { *(uint2*)(vt + (size_t)(r >> 5) * 8192 + c * 32 + (r & 31)) = pk4(v); });
    return;
  }
  t -= T2_V;
  {
    const int cg8 = (tid & 127) * 8, half = tid >> 7;
    const int tok0 = t * 64 + half * 32, tp0 = tok0 & (LSEQ - 1);
    float w[4][8], bias[8];
#pragma unroll
    for (int j = 0; j < 4; ++j) {
      float4 a = *(const float4*)(p.conv_w + j * 1024 + cg8), b = *(const float4*)(p.conv_w + j * 1024 + cg8 + 4);
      w[j][0] = a.x; w[j][1] = a.y; w[j][2] = a.z; w[j][3] = a.w; w[j][4] = b.x; w[j][5] = b.y; w[j][6] = b.z; w[j][7] = b.w;
    }
    {
      float4 a = *(const float4*)(p.conv_b + cg8), b = *(const float4*)(p.conv_b + cg8 + 4);
      bias[0] = a.x; bias[1] = a.y; bias[2] = a.z; bias[3] = a.w; bias[4] = b.x; bias[5] = b.y; bias[6] = b.z; bias[7] = b.w;
    }
    const u16* ua = (const u16*)(ws + O_UA);
    u16* cc = (u16*)(ws + O_CC);
    float h0[8], h1[8], h2[8];
    auto ld8 = [&](int tok, float* o) {
      uint4 u = *(const uint4*)(ua + (size_t)tok * 1024 + cg8);
      o[0] = __uint_as_float(u.x << 16); o[1] = __uint_as_float(u.x & 0xffff0000u);
      o[2] = __uint_as_float(u.y << 16); o[3] = __uint_as_float(u.y & 0xffff0000u);
      o[4] = __uint_as_float(u.z << 16); o[5] = __uint_as_float(u.z & 0xffff0000u);
      o[6] = __uint_as_float(u.w << 16); o[7] = __uint_as_float(u.w & 0xffff0000u);
    };
#pragma unroll
    for (int e = 0; e < 8; ++e) { h0[e] = 0.f; h1[e] = 0.f; h2[e] = 0.f; }
    if (tp0 >= 3) { ld8(tok0 - 3, h0); ld8(tok0 - 2, h1); ld8(tok0 - 1, h2); }
    for (int i0 = 0; i0 < 32; i0 += 8) {
      uint4 raw[8];
#pragma unroll
      for (int j = 0; j < 8; ++j) raw[j] = *(const uint4*)(ua + (size_t)(tok0 + i0 + j) * 1024 + cg8);
#pragma unroll
      for (int j = 0; j < 8; ++j) {
        float cur[8], o[8];
        uint4 u = raw[j];
        cur[0] = __uint_as_float(u.x << 16); cur[1] = __uint_as_float(u.x & 0xffff0000u);
        cur[2] = __uint_as_float(u.y << 16); cur[3] = __uint_as_float(u.y & 0xffff0000u);
        cur[4] = __uint_as_float(u.z << 16); cur[5] = __uint_as_float(u.z & 0xffff0000u);
        cur[6] = __uint_as_float(u.w << 16); cur[7] = __uint_as_float(u.w & 0xffff0000u);
#pragma unroll
        for (int e = 0; e < 8; ++e) {
          float a = bias[e] + w[0][e] * h0[e] + w[1][e] * h1[e] + w[2][e] * h2[e] + w[3][e] * cur[e];
          o[e] = siluf(a);
          h0[e] = h1[e]; h1[e] = h2[e]; h2[e] = cur[e];
        }
        *(uint4*)(cc + (size_t)(tok0 + i0 + j) * 1024 + cg8) = make_uint4(pk2(o[0], o[1]), pk2(o[2], o[3]), pk2(o[4], o[5]), pk2(o[6], o[7]));
      }
    }
  }
}

constexpr int T3_SCAN = 32, T3_CA = 512, T3_QK = 4096, T3_ALL = T3_SCAN + T3_CA + T3_QK;
DEVI void phase3(const P& p, char* lds, int t) {
  const int tid = tidx(), lane = tid & 63, wid = tid >> 6, wr = wid >> 1, wc = wid & 1, fr = lane & 15, fq = lane >> 4;
  char* ws = p.ws;
  if (t < T3_SCAN) {
    int gid = t * 256 + tid, pp = gid & 63, g = (gid >> 6) & 31, b = gid >> 11;
    S5gp s = s5_gp(p, g, pp);
    float ar, ai; s5_pow(s, 64.f, ar, ai);
    const float* E = (const float*)((char*)p.out + OO_E);
    u16* xp = (u16*)(ws + O_XPREV);
    float xr = 0.f, xi = 0.f;
    for (int c0 = 0; c0 < 128; c0 += 16) {
      float er[16], ei[16];
#pragma unroll
      for (int j = 0; j < 16; ++j) {
        size_t base = ((size_t)(b * 128 + c0 + j) * 32 + g) * 128;
        er[j] = E[base + pp]; ei[j] = E[base + 64 + pp];
      }
#pragma unroll
      for (int j = 0; j < 16; ++j) {
        size_t base = ((size_t)(b * 128 + c0 + j) * 32 + g) * 128;
        xp[base + pp] = f2bf(xr); xp[base + 64 + pp] = f2bf(xi);
        float nr = ar * xr - ai * xi + er[j], ni = ar * xi + ai * xr + ei[j];
        xr = nr; xi = ni;
      }
    }
    return;
  }
  t -= T3_SCAN;
  if (t < T3_CA) {
    int gid = t * 256 + tid, pp = gid & 63, j = (gid >> 6) & 63, g = gid >> 12;
    S5gp s = s5_gp(p, g, pp);
    float er, ei; s5_pow(s, (float)(j + 1), er, ei);
    u16* ca = (u16*)(ws + O_CA);
#pragma unroll
    for (int n = 0; n < 16; ++n) {
      float cr = p.C_re[(g * 16 + n) * 64 + pp], ci = p.C_im[(g * 16 + n) * 64 + pp];
      float zr = cr * er - ci * ei, zi = cr * ei + ci * er;
      size_t o = ((size_t)g * 1024 + j * 16 + n) * 128;
      ca[o + pp] = f2bf(zr); ca[o + 64 + pp] = f2bf(-zi);
    }
    return;
  }
  t -= T3_CA;
  {
    int which = t >> 11, r = t & 2047, mt = r >> 3, h = (r >> 1) & 3, nt = r & 1;
    const u16* A = (const u16*)(ws + O_CC) + (size_t)mt * 128 * 1024 + h * 256;
    const u16* B = (const u16*)(ws + (which == 0 ? O_WQT : O_WKT)) + (size_t)(h * 256 + nt * 128) * 256;
    f32x4 acc[4][4]; zero_acc(acc);
    if (which == 0) {
      gemm_plain<true>(acc, lds, A, 1024, B, 256, 4);
      u16* q = (u16*)(ws + O_QM) + (size_t)mt * 128 * 1024 + h * 256 + nt * 128;
      for_acc<true>(acc, [&](int, int, int rr, int c, f32x4 v) { *(uint2*)(q + (size_t)rr * 1024 + c) = pk4(v); });
    } else {
      gemm_plain<false>(acc, lds, A, 1024, B, 256, 4);
      int bh = (mt >> 6) * 4 + h, ch = mt & 63, tp0 = ch * 128;
      u16* km = (u16*)(ws + O_KM) + (size_t)mt * 128 * 1024 + h * 256 + nt * 128;
      u16* kts = (u16*)(ws + O_KTS) + (size_t)(bh * 64 + ch) * 32768 + (nt * 128) * 32;
      const float* ksc = (const float*)(ws + O_KSC) + (size_t)bh * LSEQ + tp0;
      float nsum[4] = {0.f, 0.f, 0.f, 0.f};
      f32x4 scv[4];
#pragma unroll
      for (int mi = 0; mi < 4; ++mi) scv[mi] = *(const f32x4*)(ksc + wr * 64 + mi * 16 + fq * 4);
      u16* lt = (u16*)lds;
      for_acc<false>(acc, [&](int mi, int ni, int rr, int c, f32x4 v) {
        f32x4 kv = v * 0.0625f;
#pragma unroll
        for (int j = 0; j < 4; ++j) lt[(rr + j) * 136 + c] = f2bf(kv[j]);
        f32x4 ks = kv * scv[mi];
        *(uint2*)(kts + (size_t)(rr >> 5) * 8192 + c * 32 + (rr & 31)) = pk4(ks);
        nsum[ni] += ks[0] + ks[1] + ks[2] + ks[3];
      });
      __syncthreads();
#pragma unroll
      for (int i = 0; i < 8; ++i) {
        int idx = tid + 256 * i, row = idx >> 4, ch = idx & 15;
        uint4 v = *(const uint4*)(lt + row * 136 + ch * 8);
        *(uint4*)(km + (size_t)row * 1024 + ch * 8) = v;
      }
      float* nlp = (float*)(ws + O_NLP) + ((size_t)(bh * 64 + ch) * 2 + wr) * 256 + nt * 128 + wc * 64;
#pragma unroll
      for (int ni = 0; ni < 4; ++ni) {
        float v = red_fq(nsum[ni]);
        if (fq == 0) nlp[ni * 16 + fr] = v;
      }
    }
  }
}

constexpr int T4_TOEP = 1024, T4_CLOC = 4096, T4_ALL = T4_TOEP + T4_CLOC;
DEVI void phase4(const P& p, char* lds, int t) {
  char* ws = p.ws;
  if (t < T4_TOEP) {
    int nt = 7 - (t >> 7), rem = t & 127, g = rem >> 2, mt = rem & 3;
    f32x4 acc[4][4]; zero_acc(acc);
    const u16* xp = (const u16*)(ws + O_XPREV) + ((size_t)mt * 128 * 32 + g) * 128;
    const u16* ca = (const u16*)(ws + O_CA) + ((size_t)g * 1024 + nt * 128) * 128;
    gemm_plain<true>(acc, lds, xp, 4096, ca, 128, 2);
    const u16* ub = (const u16*)(ws + O_UB) + (size_t)g * 524288 + (size_t)mt * 128 * 1024;
    const u16* km = (const u16*)(ws + O_KMAT) + (size_t)g * 64 * 256;
    const void* zeros = (const void*)(ws + O_BAR + 16384);
    gemm_acc<true>(acc, lds,
                   [=](int r, int k) { return (const void*)(ub + (size_t)r * 1024 + k); },
                   [=](int n, int k) {
                     int col = nt * 128 + n, lag = (col >> 4) - (k >> 4);
                     const void* z = zeros;
                     if (lag >= 0) z = (const void*)(km + ((size_t)lag * 16 + (col & 15)) * 16 + (k & 15));
                     return z;
                   },
                   2 * (nt + 1));
    u16* ys = (u16*)(ws + O_YS5);
    const u16* ubf = (const u16*)(ws + O_UB);
    uint2 upre[4][4]; f32x4 dpre[4];
    for_idx<true>([&](int mi, int ni, int r, int c) {
      int col = nt * 128 + c, j = col >> 4, ch = g * 16 + (col & 15);
      size_t tok = (size_t)(mt * 128 + r) * 64 + j;
      upre[mi][ni] = *(const uint2*)(ubf + ((size_t)g * 32768 + tok) * 16 + (col & 15));
      if (mi == 0) dpre[ni] = *(const f32x4*)(p.D_skip + ch);
    });
    for_acc<true>(acc, [&](int mi, int ni, int r, int c, f32x4 v) {
      int col = nt * 128 + c, j = col >> 4, ch = g * 16 + (col & 15);
      size_t tok = (size_t)(mt * 128 + r) * 64 + j;
      f32x4 u = unpk4(upre[mi][ni]);
      f32x4 d = dpre[ni];
      f32x4 o;
#pragma unroll
      for (int e = 0; e < 4; ++e) o[e] = geluf(v[e] + d[e] * u[e]);
      *(uint2*)(ys + kb32(tok, ch, 512)) = pk4(o);
    });
    return;
  }
  t -= T4_TOEP;
  {
    int bh = t >> 8, c = (t >> 2) & 63, dt = (t >> 1) & 1, et = t & 1;
    const u16* A = (const u16*)(ws + O_VT) + (size_t)(bh * 256 + dt * 128) * LSEQ + c * 128;
    const u16* B = (const u16*)(ws + O_KTS) + (size_t)(bh * 256 + et * 128) * LSEQ + c * 128;
    f32x4 acc[4][4]; zero_acc(acc);
    gemm_plain<true>(acc, lds, A, LSEQ, B, LSEQ, 2);
    u16* cst = (u16*)p.out + ((size_t)(bh * 64 + c) * 256 + dt * 128) * 256 + et * 128;
    for_acc<true>(acc, [&](int, int, int r, int cc, f32x4 v) { *(uint2*)(cst + (size_t)r * 256 + cc) = pk4(v); });
  }
}

constexpr int T5_GLU = 1024, T5_SCAN = 512, T5_NSCAN = 16, T5_ALL = T5_GLU + T5_SCAN + T5_NSCAN;
DEVI void phase5(const P& p, char* lds, int t) {
  const int tid = tidx();
  char* ws = p.ws;
  if (t < T5_GLU) {
    int mt = t >> 2, nt = t & 3;
    const u16* ys = (const u16*)(ws + O_YS5) + (size_t)mt * 128 * 512;
    const u16* wg = (const u16*)(ws + O_WGT) + (size_t)nt * 128 * 512;
    f32x4 acc[4][4]; zero_acc(acc);
    gemm_plain<true>(acc, lds, ys, 512, wg, 512, 8);
    u16* yb = (u16*)(ws + O_YBIN) + (size_t)mt * 128 * 512 + nt * 128;
    uint2 ypre[4][4]; f32x4 bpre[4];
    for_idx<true>([&](int mi, int ni, int r, int c) {
      ypre[mi][ni] = *(const uint2*)(ys + (size_t)r * 512 + nt * 128 + c);
      if (mi == 0) bpre[ni] = *(const f32x4*)(p.b_glu + nt * 128 + c);
    });
    for_acc<true>(acc, [&](int mi, int ni, int r, int c, f32x4 v) {
      f32x4 y = unpk4(ypre[mi][ni]);
      f32x4 bg = bpre[ni];
      f32x4 o;
#pragma unroll
      for (int e = 0; e < 4; ++e) o[e] = y[e] * sigm(v[e] + bg[e]);
      *(uint2*)(yb + (size_t)r * 512 + c) = pk4(o);
    });
    zero_acc(acc);
    const u16* xn = (const u16*)(ws + O_XN) + (size_t)mt * 128 * 1024;
    const u16* wz = (const u16*)(ws + O_WINT) + (size_t)(3584 + nt * 128) * 1024;
    gemm_plain<true>(acc, lds, xn, 1024, wz, 1024, 16);
    for_idx<true>([&](int mi, int ni, int r, int c) { ypre[mi][ni] = *(const uint2*)(yb + (size_t)r * 512 + c); });
    for_acc<true>(acc, [&](int mi, int ni, int r, int c, f32x4 v) {
      f32x4 tt = unpk4(ypre[mi][ni]);
      f32x4 o;
#pragma unroll
      for (int e = 0; e < 4; ++e) o[e] = tt[e] * siluf(v[e]);
      *(uint2*)(yb + (size_t)r * 512 + c) = pk4(o);
    });
    return;
  }
  t -= T5_GLU;
  if (t < T5_SCAN) {
    int gid = t * 256 + tid, bh = gid >> 13, i8 = gid & 8191;
    u16* cst = (u16*)p.out + (size_t)bh * 64 * 65536 + (size_t)i8 * 8;
    const float* ach = (const float*)(ws + O_ACH) + bh * 64;
    float* la = (float*)lds;
    __syncthreads();
    if (tid < 64) la[tid] = ach[tid];
    __syncthreads();
    float st[8];
#pragma unroll
    for (int e = 0; e < 8; ++e) st[e] = 0.f;
    for (int c0 = 0; c0 < 64; c0 += 16) {
      uint4 ub[16];
#pragma unroll
      for (int j = 0; j < 16; ++j) ub[j] = *(const uint4*)(cst + (size_t)(c0 + j) * 65536);
#pragma unroll
      for (int j = 0; j < 16; ++j) {
        uint4 u = ub[j];
        *(uint4*)(cst + (size_t)(c0 + j) * 65536) = make_uint4(pk2(st[0], st[1]), pk2(st[2], st[3]), pk2(st[4], st[5]), pk2(st[6], st[7]));
        float a = la[c0 + j];
        st[0] = a * st[0] + __uint_as_float(u.x << 16); st[1] = a * st[1] + __uint_as_float(u.x & 0xffff0000u);
        st[2] = a * st[2] + __uint_as_float(u.y << 16); st[3] = a * st[3] + __uint_as_float(u.y & 0xffff0000u);
        st[4] = a * st[4] + __uint_as_float(u.z << 16); st[5] = a * st[5] + __uint_as_float(u.z & 0xffff0000u);
        st[6] = a * st[6] + __uint_as_float(u.w << 16); st[7] = a * st[7] + __uint_as_float(u.w & 0xffff0000u);
      }
    }
    return;
  }
}


DEVI void cstate_task(const P& p, char* lds, int task, int vb) {
  const int tid = tidx(), lane = tid & 63, wid = tid >> 6, wr = wid >> 1, wc = wid & 1, fr = lane & 15, fq = lane >> 4;
  char* ws = p.ws;
  const int bh = task >> 2, dt = (task >> 1) & 1, et = task & 1;
  const int nk = 256;
  if (vb == 1) {
    const u16* A = (const u16*)(ws + O_VT) + (size_t)(bh * 64) * 32768 + (dt * 128) * 32;
    const u16* B = (const u16*)(ws + O_KTS) + (size_t)(bh * 64) * 32768 + (et * 128) * 32;
    const int sb = (tid & 63) * 16;
    const int swz = sb ^ (((sb >> 9) & 1) << 5);
    const int R0 = (tid >> 6) * 16 + (swz >> 6);
    const int C0 = (swz & 63) >> 1;
    const int wofs = tid * 16;
    const u16* a0 = A + (size_t)R0 * 32 + C0;
    const u16* a1 = A + (size_t)(R0 + 64) * 32 + C0;
    const u16* b0 = B + (size_t)R0 * 32 + C0;
    const u16* b1 = B + (size_t)(R0 + 64) * 32 + C0;
    asm volatile("s_waitcnt vmcnt(0)" ::: "memory");
    __syncthreads();
#pragma unroll
    for (int s0 = 0; s0 < 7; ++s0) {
      char* sg = lds + s0 * 16384;
      const int ko0 = s0 * 8192;
      glds16(a0 + ko0, sg + wofs); glds16(a1 + ko0, sg + wofs + 4096);
      glds16(b0 + ko0, sg + 8192 + wofs); glds16(b1 + ko0, sg + 8192 + wofs + 4096);
    }
#pragma unroll 1
    for (int ks = 0; ks < nk; ++ks) {
      const int rem = nk - 1 - ks;
      if (rem >= 6) asm volatile("s_waitcnt vmcnt(24)" ::: "memory");
      else if (rem == 5) asm volatile("s_waitcnt vmcnt(20)" ::: "memory");
      else if (rem == 4) asm volatile("s_waitcnt vmcnt(16)" ::: "memory");
      else if (rem == 3) asm volatile("s_waitcnt vmcnt(12)" ::: "memory");
      else if (rem == 2) asm volatile("s_waitcnt vmcnt(8)" ::: "memory");
      else if (rem == 1) asm volatile("s_waitcnt vmcnt(4)" ::: "memory");
      else asm volatile("s_waitcnt vmcnt(0)" ::: "memory");
      __syncthreads();
      if (ks + 7 < nk) {
        char* sg = lds + ((ks + 7) & 7) * 16384;
        const int ko = (ks + 7) * 8192;
        glds16(a0 + ko, sg + wofs); glds16(a1 + ko, sg + wofs + 4096);
        glds16(b0 + ko, sg + 8192 + wofs); glds16(b1 + ko, sg + 8192 + wofs + 4096);
      }
    }
    __syncthreads();
  } else {
    const float achv = ((const float*)(ws + O_ACH))[bh * 64 + lane];
    f32x4 acc[4][4], st[4][4];
    zero_acc(acc); zero_acc(st);
    const int lo = ((fr * 64 + fq * 16) ^ ((fr >> 3) << 5));
    __syncthreads();
#pragma unroll 1
    for (int ks = 0; ks < nk; ++ks) {
      __syncthreads();
      const char* cur = lds + (ks & 7) * 16384;
      bf16x8 af[4], bfr[4];
#pragma unroll
      for (int mi = 0; mi < 4; ++mi) af[mi] = *(const bf16x8*)(cur + (wr * 4 + mi) * 1024 + lo);
#pragma unroll
      for (int ni = 0; ni < 4; ++ni) bfr[ni] = *(const bf16x8*)(cur + 8192 + (wc * 4 + ni) * 1024 + lo);
#pragma unroll
      for (int mi = 0; mi < 4; ++mi)
#pragma unroll
        for (int ni = 0; ni < 4; ++ni) acc[mi][ni] = __builtin_amdgcn_mfma_f32_16x16x32_bf16(bfr[ni], af[mi], acc[mi][ni], 0, 0, 0);
      if ((ks & 3) == 3) {
        const int c = ks >> 2;
        const float a = __shfl(achv, c);
        u16* cst = (u16*)p.out + ((size_t)(bh * 64 + c) * 256 + dt * 128 + wr * 64 + fr) * 256 + et * 128 + wc * 64 + fq * 4;
#pragma unroll
        for (int mi = 0; mi < 4; ++mi)
#pragma unroll
          for (int ni = 0; ni < 4; ++ni) {
            *(uint2*)(cst + (size_t)(mi * 16) * 256 + ni * 16) = pk4(st[mi][ni]);
            st[mi][ni] = st[mi][ni] * a + acc[mi][ni];
            acc[mi][ni] = f32x4{0.f, 0.f, 0.f, 0.f};
          }
      }
    }
    __syncthreads();
  }
}


DEVI void wait_vm_even(int n) {
  switch (n) {
    case 0: asm volatile("s_waitcnt vmcnt(0)" ::: "memory"); break;
    case 2: asm volatile("s_waitcnt vmcnt(2)" ::: "memory"); break;
    case 4: asm volatile("s_waitcnt vmcnt(4)" ::: "memory"); break;
    case 6: asm volatile("s_waitcnt vmcnt(6)" ::: "memory"); break;
    case 8: asm volatile("s_waitcnt vmcnt(8)" ::: "memory"); break;
    case 10: asm volatile("s_waitcnt vmcnt(10)" ::: "memory"); break;
    case 12: asm volatile("s_waitcnt vmcnt(12)" ::: "memory"); break;
    case 14: asm volatile("s_waitcnt vmcnt(14)" ::: "memory"); break;
    case 16: asm volatile("s_waitcnt vmcnt(16)" ::: "memory"); break;
    case 18: asm volatile("s_waitcnt vmcnt(18)" ::: "memory"); break;
    case 20: asm volatile("s_waitcnt vmcnt(20)" ::: "memory"); break;
    case 22: asm volatile("s_waitcnt vmcnt(22)" ::: "memory"); break;
    case 24: asm volatile("s_waitcnt vmcnt(24)" ::: "memory"); break;
    case 26: asm volatile("s_waitcnt vmcnt(26)" ::: "memory"); break;
    default: asm volatile("s_waitcnt vmcnt(28)" ::: "memory"); break;
  }
}
DEVI void cstate64_task(const P& p, char* lds, int task, int vb) {
  const int tid = tidx(), lane = tid & 63, wid = tid >> 6, wr = wid >> 1, wc = wid & 1, fr = lane & 15, fq = lane >> 4;
  char* ws = p.ws;
  const int bh = task >> 4, dt = (task >> 2) & 3, et = task & 3;
  const int nk = 256;
  if (vb == 1) {
    const int sb = (tid & 63) * 16;
    const int swz = sb ^ (((sb >> 9) & 1) << 5);
    const int R = (tid >> 6) * 16 + (swz >> 6);
    const int C = (swz & 63) >> 1;
    const u16* a0 = (const u16*)(ws + O_VT) + (size_t)(bh * 64) * 32768 + (dt * 64 + R) * 32 + C;
    const u16* b0 = (const u16*)(ws + O_KTS) + (size_t)(bh * 64) * 32768 + (et * 64 + R) * 32 + C;
    const int wofs = tid * 16;
    asm volatile("s_waitcnt vmcnt(0)" ::: "memory");
    __syncthreads();
#pragma unroll
    for (int s0 = 0; s0 < 15; ++s0) {
      char* sg = lds + s0 * 8192;
      glds16(a0 + s0 * 8192, sg + wofs); glds16(b0 + s0 * 8192, sg + 4096 + wofs);
    }
#pragma unroll 1
    for (int ks = 0; ks < nk; ++ks) {
      const int rem = nk - 1 - ks;
      wait_vm_even(rem >= 14 ? 28 : 2 * rem);
      __syncthreads();
      if (ks + 15 < nk) {
        char* sg = lds + ((ks + 15) & 15) * 8192;
        glds16(a0 + (size_t)(ks + 15) * 8192, sg + wofs); glds16(b0 + (size_t)(ks + 15) * 8192, sg + 4096 + wofs);
      }
    }
    __syncthreads();
  } else {
    const float achv = ((const float*)(ws + O_ACH))[bh * 64 + lane];
    f32x4 acc[2][2], st[2][2];
#pragma unroll
    for (int i = 0; i < 2; ++i)
#pragma unroll
      for (int j = 0; j < 2; ++j) { acc[i][j] = f32x4{0.f, 0.f, 0.f, 0.f}; st[i][j] = f32x4{0.f, 0.f, 0.f, 0.f}; }
    const int lo = ((fr * 64 + fq * 16) ^ ((fr >> 3) << 5));
    __syncthreads();
#pragma unroll 1
    for (int ks = 0; ks < nk; ++ks) {
      __syncthreads();
      const char* cur = lds + (ks & 15) * 8192;
      bf16x8 af[2], bfr[2];
#pragma unroll
      for (int mi = 0; mi < 2; ++mi) af[mi] = *(const bf16x8*)(cur + (wr * 2 + mi) * 1024 + lo);
#pragma unroll
      for (int ni = 0; ni < 2; ++ni) bfr[ni] = *(const bf16x8*)(cur + 4096 + (wc * 2 + ni) * 1024 + lo);
#pragma unroll
      for (int mi = 0; mi < 2; ++mi)
#pragma unroll
        for (int ni = 0; ni < 2; ++ni) acc[mi][ni] = __builtin_amdgcn_mfma_f32_16x16x32_bf16(bfr[ni], af[mi], acc[mi][ni], 0, 0, 0);
      if ((ks & 3) == 3) {
        const int c = ks >> 2;
        const float a = __shfl(achv, c);
        u16* cst = (u16*)p.out + ((size_t)(bh * 64 + c) * 256 + dt * 64 + wr * 32 + fr) * 256 + et * 64 + wc * 32 + fq * 4;
#pragma unroll
        for (int mi = 0; mi < 2; ++mi)
#pragma unroll
          for (int ni = 0; ni < 2; ++ni) {
            *(uint2*)(cst + (size_t)(mi * 16) * 256 + ni * 16) = pk4(st[mi][ni]);
            st[mi][ni] = st[mi][ni] * a + acc[mi][ni];
            acc[mi][ni] = f32x4{0.f, 0.f, 0.f, 0.f};
          }
      }
    }
    __syncthreads();
  }
}

DEVI void nscan_tile(const P& p, char* lds, int t) {
  const int tid = tidx();
  char* ws = p.ws;
  {
    int bh = t, e = tid;
    const float* nlp = (const float*)(ws + O_NLP) + (size_t)bh * 64 * 512;
    float* np = (float*)(ws + O_NPREV) + (size_t)bh * 64 * 256;
    const float* ach = (const float*)(ws + O_ACH) + bh * 64;
    float* la = (float*)lds;
    __syncthreads();
    if (tid < 64) la[tid] = ach[tid];
    __syncthreads();
    float st = 0.f;
    for (int c0 = 0; c0 < 64; c0 += 16) {
      float n0[16], n1[16];
#pragma unroll
      for (int j = 0; j < 16; ++j) { n0[j] = nlp[(c0 + j) * 512 + e]; n1[j] = nlp[(c0 + j) * 512 + 256 + e]; }
#pragma unroll
      for (int j = 0; j < 16; ++j) {
        np[(c0 + j) * 256 + e] = st;
        st = la[c0 + j] * st + n0[j] + n1[j];
      }
    }
  }
}

DEVI void phase6(const P& p, char* lds, int t) {
  const int tid = tidx(), lane = tid & 63, wid = tid >> 6, wr = wid >> 1, wc = wid & 1, fr = lane & 15, fq = lane >> 4;
  char* ws = p.ws;
  int bh = t >> 6, c = t & 63, b = bh >> 2, h = bh & 3;
  size_t tok0 = (size_t)b * LSEQ + c * 128;
  const u16* Q = (const u16*)(ws + O_QM) + tok0 * 1024 + h * 256;
  const u16* K = (const u16*)(ws + O_KM) + tok0 * 1024 + h * 256;
  f32x4 acc[4][4]; zero_acc(acc);
  gemm_plain<true>(acc, lds, Q, 1024, K, 1024, 4);
  const size_t g0 = (size_t)bh * LSEQ + c * 128;
  const float* alpha = (const float*)(ws + O_ALPHA) + g0;
  const float* rs = (const float*)(ws + O_RS) + g0;
  u16* pm = (u16*)(ws + O_PMAT) + g0 * 128;
  float rowp[4] = {0.f, 0.f, 0.f, 0.f};
  float alp[4]; f32x4 rvp[4];
#pragma unroll
  for (int i = 0; i < 4; ++i) { alp[i] = alpha[wr * 64 + i * 16 + fr]; rvp[i] = *(const f32x4*)(rs + wc * 64 + i * 16 + fq * 4); }
  for_acc<true>(acc, [&](int mi, int ni, int r, int cc, f32x4 v) {
    float al = alp[mi];
    f32x4 rv = rvp[ni];
    f32x4 o;
#pragma unroll
    for (int e = 0; e < 4; ++e) {
      float d = (cc + e <= r) ? __expf(al + rv[e]) : 0.f;
      o[e] = v[e] * d;
    }
    rowp[mi] += o[0] + o[1] + o[2] + o[3];
    *(uint2*)(pm + (size_t)r * 128 + cc) = pk4(o);
  });
  float* lf = (float*)lds;
#pragma unroll
  for (int mi = 0; mi < 4; ++mi) {
    float v = red_fq(rowp[mi]);
    if (fq == 0) lf[wc * 128 + wr * 64 + mi * 16 + fr] = v;
  }
  __syncthreads();
  {
    int tt = tid >> 1, hf = tid & 1;
    const u16* qrow = Q + (size_t)tt * 1024 + hf * 128;
    const float* np = (const float*)(ws + O_NPREV) + (size_t)(bh * 64 + c) * 256 + hf * 128;
    float dot = 0.f;
#pragma unroll 4
    for (int i = 0; i < 16; ++i) {
      uint4 u = *(const uint4*)(qrow + i * 8);
      float4 n0 = *(const float4*)(np + i * 8), n1 = *(const float4*)(np + i * 8 + 4);
      dot += __uint_as_float(u.x << 16) * n0.x + __uint_as_float(u.x & 0xffff0000u) * n0.y +
             __uint_as_float(u.y << 16) * n0.z + __uint_as_float(u.y & 0xffff0000u) * n0.w +
             __uint_as_float(u.z << 16) * n1.x + __uint_as_float(u.z & 0xffff0000u) * n1.y +
             __uint_as_float(u.w << 16) * n1.z + __uint_as_float(u.w & 0xffff0000u) * n1.w;
    }
    dot += __shfl_xor(dot, 1);
    if (hf == 0) {
      float inter = ((const float*)(ws + O_INTER))[g0 + tt];
      float emt = ((const float*)(ws + O_EMT))[g0 + tt];
      float den = lf[tt] + lf[128 + tt] + inter * dot;
      ((float*)(ws + O_RDEN))[g0 + tt] = 1.f / fmaxf(fabsf(den), emt);
    }
  }
}

DEVI void phase7(const P& p, char* lds, int t) {
  const int tid = tidx(), lane = tid & 63, wid = tid >> 6, wr = wid >> 1, fr = lane & 15;
  char* ws = p.ws;
  int bh = t >> 7, c = (t >> 1) & 63, dt = t & 1, b = bh >> 2, h = bh & 3;
  size_t tok0 = (size_t)b * LSEQ + c * 128;
  const size_t g0 = (size_t)bh * LSEQ + c * 128;
  const u16* Q = (const u16*)(ws + O_QM) + tok0 * 1024 + h * 256;
  const u16* Cp = (const u16*)p.out + ((size_t)(bh * 64 + c) * 256 + dt * 128) * 256;
  f32x4 acc[4][4]; zero_acc(acc);
  gemm_plain<true>(acc, lds, Q, 1024, Cp, 256, 4);
  const float* inter = (const float*)(ws + O_INTER) + g0;
#pragma unroll
  for (int mi = 0; mi < 4; ++mi) {
    float it = inter[wr * 64 + mi * 16 + fr];
#pragma unroll
    for (int ni = 0; ni < 4; ++ni) acc[mi][ni] *= it;
  }
  const u16* pm = (const u16*)(ws + O_PMAT) + g0 * 128;
  const u16* vt = (const u16*)(ws + O_VT) + (size_t)(bh * 64 + c) * 32768 + (dt * 128) * 32;
  gemm_acc<true>(acc, lds, [=](int r, int k) { return (const void*)(pm + (size_t)r * 128 + k); },
                 [=](int n, int k) { return (const void*)(vt + (size_t)(k >> 5) * 8192 + n * 32 + (k & 31)); }, 2);
  const float* rden = (const float*)(ws + O_RDEN) + g0;
  u16* hb = (u16*)(ws + O_HBUF);
  float rdp[4];
#pragma unroll
  for (int i = 0; i < 4; ++i) rdp[i] = rden[wr * 64 + i * 16 + fr];
  for_acc<true>(acc, [&](int mi, int, int r, int cc, f32x4 v) {
    *(uint2*)(hb + kb32(tok0 + r, h * 256 + dt * 128 + cc, 1024)) = pk4(v * rdp[mi]);
  });
}

DEVI void phase75(const P& p, char* lds, int t) {
  const int tid = tidx(), lane = tid & 63, wid = tid >> 6, wr = wid >> 1, wc = wid & 1, fr = lane & 15, fq = lane >> 4;
  char* ws = p.ws;
  int mt = t >> 3, nt = t & 7;
  const u16* xn = (const u16*)(ws + O_XN) + (size_t)mt * 128 * 1024;
  const u16* w = (const u16*)(ws + O_WINT) + (size_t)(2048 + nt * 128) * 1024;
  f32x4 acc[4][4]; zero_acc(acc);
  gemm_plain<true>(acc, lds, xn, 1024, w, 1024, 16);
  u16* hb = (u16*)(ws + O_HBUF) + (size_t)mt * 128 * 1024 + nt * 128;
  float sq[4] = {0.f, 0.f, 0.f, 0.f};
  uint2 hpre[4][4];
  for_idx<true>([&](int mi, int ni, int r, int c) { hpre[mi][ni] = *(const uint2*)(hb + (size_t)r * 1024 + c); });
  for_acc<true>(acc, [&](int mi, int ni, int r, int c, f32x4 v) {
    f32x4 hv = unpk4(hpre[mi][ni]);
    f32x4 o;
#pragma unroll
    for (int e = 0; e < 4; ++e) { o[e] = sigm(v[e]) * hv[e]; sq[mi] += o[e] * o[e]; }
    *(uint2*)(hb + (size_t)r * 1024 + c) = pk4(o);
  });
  float* hs = (float*)(ws + O_HSQP);
#pragma unroll
  for (int mi = 0; mi < 4; ++mi) {
    float v = red_fq(sq[mi]);
    if (fq == 0) hs[(size_t)(mt * 128 + wr * 64 + mi * 16 + fr) * 16 + (nt >> 1) * 4 + (nt & 1) * 2 + wc] = v;
  }
}
DEVI void phase8(const P& p, char* lds, int t) {
  char* ws = p.ws;
  int mt = t >> 3, nt = t & 7;
  const u16* xn = (const u16*)(ws + O_XN) + (size_t)mt * 128 * 1024;
  const u16* w = (const u16*)(ws + O_WINT) + (size_t)(1024 + nt * 128) * 1024;
  f32x4 acc[4][4]; zero_acc(acc);
  gemm_plain<true>(acc, lds, xn, 1024, w, 1024, 16);
  u16* hb = (u16*)(ws + O_HBUF) + (size_t)mt * 128 * 1024 + nt * 128;
  const u16* cc = (const u16*)(ws + O_CC) + (size_t)mt * 128 * 1024 + nt * 128;
  const float* hs = (const float*)(ws + O_HSQP);
  uint2 hpre[4][4], cpre[4][4]; float rsp[4]; f32x4 hgp[4], skp[4];
  for_idx<true>([&](int mi, int ni, int r, int c) {
    hpre[mi][ni] = *(const uint2*)(hb + (size_t)r * 1024 + c);
    cpre[mi][ni] = *(const uint2*)(cc + (size_t)r * 1024 + c);
    if (ni == 0) {
      float4 s4 = *(const float4*)(hs + (size_t)(mt * 128 + r) * 16 + (nt >> 1) * 4);
      rsp[mi] = rsqrtf((s4.x + s4.y + s4.z + s4.w) * (1.f / 256.f) + 1e-6f);
    }
    if (mi == 0) { hgp[ni] = *(const f32x4*)(p.head_g + nt * 128 + c); skp[ni] = *(const f32x4*)(p.skip_a + nt * 128 + c); }
  });
  for_acc<true>(acc, [&](int mi, int ni, int r, int c, f32x4 v) {
    float rstd = rsp[mi];
    f32x4 hv = unpk4(hpre[mi][ni]);
    f32x4 cv = unpk4(cpre[mi][ni]);
    f32x4 hg = hgp[ni];
    f32x4 sk = skp[ni];
    f32x4 o;
#pragma unroll
    for (int e = 0; e < 4; ++e) o[e] = siluf(v[e]) * (hv[e] * rstd * hg[e] + sk[e] * cv[e]);
    *(uint2*)(hb + (size_t)r * 1024 + c) = pk4(o);
  });
}
DEVI void phase85(const P& p, char* lds, int t) {
  char* ws = p.ws;
  int mt = t >> 4, nt = t & 15;
  const u16* xn = (const u16*)(ws + O_XN) + (size_t)mt * 128 * 1024;
  const u16* w = (const u16*)(ws + O_WINT) + (size_t)(4096 + nt * 128) * 1024;
  f32x4 acc[4][4]; zero_acc(acc);
  gemm_plain<true>(acc, lds, xn, 1024, w, 1024, 16);
  u16* sg = (u16*)(ws + O_SG) + (size_t)mt * 128 * 2048 + nt * 128;
  for_acc<true>(acc, [&](int, int, int r, int c, f32x4 v) {
    f32x4 o;
#pragma unroll
    for (int e = 0; e < 4; ++e) o[e] = sigm(v[e]);
    *(uint2*)(sg + (size_t)r * 2048 + c) = pk4(o);
  });
}
DEVI void phase9(const P& p, char* lds, int t) {
  char* ws = p.ws;
  int mt = t >> 3, nt = t & 7;
  const u16* yb = (const u16*)(ws + O_YBIN) + (size_t)mt * 128 * 512;
  const u16* wb = (const u16*)(ws + O_WBT) + (size_t)nt * 128 * 512;
  f32x4 acc[4][4]; zero_acc(acc);
  gemm_plain<true>(acc, lds, yb, 512, wb, 512, 8);
  const u16* sg = (const u16*)(ws + O_SG) + (size_t)mt * 128 * 2048 + nt * 128;
  for_acc<true>(acc, [&](int mi, int ni, int r, int c, f32x4 v) {
    f32x4 ga = unpk4(*(const uint2*)(sg + (size_t)r * 2048 + c));
    f32x4 gb = unpk4(*(const uint2*)(sg + (size_t)r * 2048 + 1024 + c));
#pragma unroll
    for (int e = 0; e < 4; ++e) acc[mi][ni][e] = v[e] * gb[e] / ga[e];
  });
  const u16* ya = (const u16*)(ws + O_HBUF) + (size_t)mt * 128 * 1024;
  const u16* wa = (const u16*)(ws + O_WAT) + (size_t)nt * 128 * 1024;
  gemm_plain<true>(acc, lds, ya, 1024, wa, 1024, 16);
  u16* mg = (u16*)(ws + O_MERGED) + (size_t)mt * 128 * 1024 + nt * 128;
  uint2 gpre[4][4];
  for_idx<true>([&](int mi, int ni, int r, int c) { gpre[mi][ni] = *(const uint2*)(sg + (size_t)r * 2048 + c); });
  for_acc<true>(acc, [&](int mi, int ni, int r, int c, f32x4 v) {
    f32x4 ga = unpk4(gpre[mi][ni]);
    *(uint2*)(mg + (size_t)r * 1024 + c) = pk4(v * ga);
  });
}
DEVI void phase10(const P& p, char* lds, int t) {
  const int tid = tidx(), lane = tid & 63, wid = tid >> 6, wr = wid >> 1, wc = wid & 1, fr = lane & 15, fq = lane >> 4;
  char* ws = p.ws;
  int mt = t >> 3, nt = t & 7;
  const u16* mg = (const u16*)(ws + O_MERGED) + (size_t)mt * 128 * 1024;
  const u16* wo = (const u16*)(ws + O_WOT) + (size_t)nt * 128 * 1024;
  f32x4 acc[4][4]; zero_acc(acc);
  gemm_plain<true>(acc, lds, mg, 1024, wo, 1024, 16);
  float* o = p.out + (size_t)mt * 128 * 1024 + nt * 128;
  float sq[4] = {0.f, 0.f, 0.f, 0.f};
  for_acc<true>(acc, [&](int mi, int, int r, int c, f32x4 v) {
    *(f32x4*)(o + (size_t)r * 1024 + c) = v;
    sq[mi] += v[0] * v[0] + v[1] * v[1] + v[2] * v[2] + v[3] * v[3];
  });
  float* rq = (float*)(ws + O_RSQP);
#pragma unroll
  for (int mi = 0; mi < 4; ++mi) {
    float v = red_fq(sq[mi]);
    if (fq == 0) rq[(size_t)(mt * 128 + wr * 64 + mi * 16 + fr) * 16 + nt * 2 + wc] = v;
  }
}
DEVI void phase11(const P& p, int t) {
  const int tid = tidx(), lane = tid & 63;
  size_t row = (size_t)t * 4 + (tid >> 6);
  const float* rq = (const float*)(p.ws + O_RSQP) + row * 16;
  float4 a = *(const float4*)(rq), b = *(const float4*)(rq + 4), c = *(const float4*)(rq + 8), d = *(const float4*)(rq + 12);
  float ss = ((a.x + a.y) + (a.z + a.w)) + ((b.x + b.y) + (b.z + b.w)) + ((c.x + c.y) + (c.z + c.w)) + ((d.x + d.y) + (d.z + d.w));
  float rstd = rsqrtf(ss * (1.f / 1024.f) + 1e-6f);
  float4 rr[4], xx[4], gg[4];
#pragma unroll
  for (int j = 0; j < 4; ++j) {
    int k = j * 256 + lane * 4;
    f32x4 r4 = unpk4(*(const uint2*)((const u16*)(p.ws + O_R16) + row * 1024 + k));
    rr[j] = make_float4(r4[0], r4[1], r4[2], r4[3]);
    xx[j] = *(const float4*)(p.x + row * 1024 + k);
    gg[j] = *(const float4*)(p.norm_post_g + k);
  }
#pragma unroll
  for (int j = 0; j < 4; ++j) {
    int k = j * 256 + lane * 4;
    float4 r = rr[j], xv = xx[j], g = gg[j];
    float4 o = make_float4(xv.x + r.x * rstd * g.x, xv.y + r.y * rstd * g.y, xv.z + r.z * rstd * g.z, xv.w + r.w * rstd * g.w);
    *(float4*)(p.out + row * 1024 + k) = o;
  }
}


DEVI void b_phase1(const P& p, char* lds, int t) {
  char* ws = p.ws;
  int mt = t / 6, nt = t % 6;
  const u16* A = (const u16*)(ws + O_XN) + (size_t)mt * 32 * 8192;
  int wrow = nt < 4 ? nt * 256 : 3072 + (nt - 4) * 256;
  const u16* B = (const u16*)(ws + O_WINT) + (size_t)(wrow >> 8) * 32 * 8192;
  f32x4 acc[8][4]; zero_acc8(acc);
  gemm8_kb(acc, lds, A, B, 32);
  if (nt < 4) {
    u16* dst = (u16*)(ws + O_UA) + (size_t)mt * 256 * 1024 + nt * 256;
    epi8(acc, [&](int, int, int, int) {}, [&](int, int, int, int r, int c, f32x4& v) { *(uint2*)(dst + (size_t)r * 1024 + c) = pk4(v); });
  } else {
    u16* ubg = (u16*)(ws + O_UB);
    epi8(acc, [&](int, int, int, int) {}, [&](int, int, int, int r, int c, f32x4& v) {
      int ch = (nt - 4) * 256 + c;
      *(uint2*)(ubg + ((size_t)(ch >> 4) * 32768 + (size_t)mt * 256 + r) * 16 + (ch & 15)) = pk4(v);
    });
  }
}
DEVI void b_glu(const P& p, char* lds, int t) {
  char* ws = p.ws;
  int mt = t >> 1, nt = t & 1;
  const u16* ys = (const u16*)(ws + O_YS5) + (size_t)mt * 16 * 8192;
  const u16* wg = (const u16*)(ws + O_WGT) + (size_t)nt * 16 * 8192;
  f32x4 acc[8][4]; zero_acc8(acc);
  gemm8_kb(acc, lds, ys, wg, 16);
  u16* yb = (u16*)(ws + O_YBIN) + (size_t)mt * 16 * 8192;
  uint2 ypre[4][4]; f32x4 bpre[4];
  epi8<2>(acc,
       [&](int m, int ni, int r, int c) {
         ypre[m][ni] = *(const uint2*)(ys + kb32(r, nt * 256 + c, 512));
         if (m == 0) bpre[ni] = *(const f32x4*)(p.b_glu + nt * 256 + c);
       },
       [&](int m, int, int ni, int r, int c, f32x4& v) {
         f32x4 y = unpk4(ypre[m][ni]), bg = bpre[ni], o;
#pragma unroll
         for (int e = 0; e < 4; ++e) o[e] = y[e] * sigm(v[e] + bg[e]);
         *(uint2*)(yb + kb32(r, nt * 256 + c, 512)) = pk4(o);
       });
  zero_acc8(acc);
  const u16* xn = (const u16*)(ws + O_XN) + (size_t)mt * 32 * 8192;
  const u16* wz = (const u16*)(ws + O_WINT) + (size_t)(14 + nt) * 32 * 8192;
  gemm8_kb(acc, lds, xn, wz, 32);
  epi8<2>(acc, [&](int m, int ni, int r, int c) { ypre[m][ni] = *(const uint2*)(yb + kb32(r, nt * 256 + c, 512)); },
       [&](int m, int, int ni, int r, int c, f32x4& v) {
         f32x4 tt = unpk4(ypre[m][ni]), o;
#pragma unroll
         for (int e = 0; e < 4; ++e) o[e] = tt[e] * siluf(v[e]);
         *(uint2*)(yb + kb32(r, nt * 256 + c, 512)) = pk4(o);
       });
}
DEVI void b_phase75(const P& p, char* lds, int t, bool dry = false) {
  const int tid = tidx512(), lane = tid & 63, wid = tid >> 6, wr = wid >> 2, wc = wid & 3, fr = lane & 15, fq = lane >> 4;
  char* ws = p.ws;
  int mt = t >> 2, nt = t & 3;
  const u16* xn = (const u16*)(ws + O_XN) + (size_t)mt * 32 * 8192;
  const u16* w = (const u16*)(ws + O_WINT) + (size_t)(8 + nt) * 32 * 8192;
  f32x4 acc[8][4]; zero_acc8(acc);
  gemm8_kb(acc, lds, xn, w, 32);
  u16* hb = (u16*)(ws + O_HBUF) + (size_t)mt * 32 * 8192;
  u16* hbw = dry ? (u16*)(ws + O_QM) + (size_t)mt * 32 * 8192 : hb;
  float sq[8] = {0.f, 0.f, 0.f, 0.f, 0.f, 0.f, 0.f, 0.f};
  uint2 hpre[4][4];
  epi8<2>(acc, [&](int m, int ni, int r, int c) { hpre[m][ni] = *(const uint2*)(hb + kb32(r, nt * 256 + c, 1024)); },
       [&](int m, int mg, int ni, int r, int c, f32x4& v) {
         f32x4 hv = unpk4(hpre[m][ni]), o;
#pragma unroll
         for (int e = 0; e < 4; ++e) { o[e] = sigm(v[e]) * hv[e]; sq[mg] += o[e] * o[e]; }
         *(uint2*)(hbw + kb32(r, nt * 256 + c, 1024)) = pk4(o);
       });
  float* hs = dry ? (float*)(ws + O_KM) : (float*)(ws + O_HSQP);
#pragma unroll
  for (int mg = 0; mg < 8; ++mg) {
    float v = red_fq(sq[mg]);
    if (fq == 0) hs[(size_t)(mt * 256 + wr * 128 + mg * 16 + fr) * 16 + nt * 4 + wc] = v;
  }
}
DEVI void b_phase8(const P& p, char* lds, int t, bool dry = false) {
  char* ws = p.ws;
  int mt = t >> 2, nt = t & 3;
  const u16* xn = (const u16*)(ws + O_XN) + (size_t)mt * 32 * 8192;
  const u16* w = (const u16*)(ws + O_WINT) + (size_t)(4 + nt) * 32 * 8192;
  f32x4 acc[8][4]; zero_acc8(acc);
  gemm8_kb(acc, lds, xn, w, 32);
  u16* hb = (u16*)(ws + O_HBUF) + (size_t)mt * 32 * 8192;
  u16* hbw = dry ? (u16*)(ws + O_QM) + (size_t)mt * 32 * 8192 : hb;
  const u16* cc = (const u16*)(ws + O_CC) + (size_t)mt * 256 * 1024 + nt * 256;
  const float* hs = (const float*)(ws + O_HSQP);
  uint2 hpre[4][4], cpre[4][4]; float rsp[4]; f32x4 hgp[4], skp[4];
  epi8<1>(acc,
       [&](int m, int ni, int r, int c) {
         hpre[m][ni] = *(const uint2*)(hb + kb32(r, nt * 256 + c, 1024));
         cpre[m][ni] = *(const uint2*)(cc + (size_t)r * 1024 + c);
         if (ni == 0) {
           float4 s4 = *(const float4*)(hs + (size_t)(mt * 256 + r) * 16 + nt * 4);
           rsp[m] = rsqrtf((s4.x + s4.y + s4.z + s4.w) * (1.f / 256.f) + 1e-6f);
         }
         if (m == 0) { hgp[ni] = *(const f32x4*)(p.head_g + nt * 256 + c); skp[ni] = *(const f32x4*)(p.skip_a + nt * 256 + c); }
       },
       [&](int m, int, int ni, int r, int c, f32x4& v) {
         float rstd = rsp[m];
         f32x4 hv = unpk4(hpre[m][ni]), cv = unpk4(cpre[m][ni]), hg = hgp[ni], sk = skp[ni], o;
#pragma unroll
         for (int e = 0; e < 4; ++e) o[e] = siluf(v[e]) * (hv[e] * rstd * hg[e] + sk[e] * cv[e]);
         *(uint2*)(hbw + kb32(r, nt * 256 + c, 1024)) = pk4(o);
       });
}
DEVI void b_phase85(const P& p, char* lds, int t) {
  char* ws = p.ws;
  int mt = t >> 3, nt = t & 7;
  const u16* xn = (const u16*)(ws + O_XN) + (size_t)mt * 32 * 8192;
  const u16* w = (const u16*)(ws + O_WINT) + (size_t)(16 + nt) * 32 * 8192;
  f32x4 acc[8][4]; zero_acc8(acc);
  gemm8_kb(acc, lds, xn, w, 32);
  u16* sg = (u16*)(ws + O_SG) + (size_t)mt * 256 * 2048 + nt * 256;
  epi8(acc, [&](int, int, int, int) {}, [&](int, int, int, int r, int c, f32x4& v) {
    f32x4 o;
#pragma unroll
    for (int e = 0; e < 4; ++e) o[e] = sigm(v[e]);
    *(uint2*)(sg + (size_t)r * 2048 + c) = pk4(o);
  });
}
DEVI void b_phase9(const P& p, char* lds, int t) {
  char* ws = p.ws;
  int mt = t >> 2, nt = t & 3;
  const u16* yb = (const u16*)(ws + O_YBIN) + (size_t)mt * 16 * 8192;
  const u16* wb = (const u16*)(ws + O_WBT) + (size_t)nt * 16 * 8192;
  f32x4 acc[8][4]; zero_acc8(acc);
  gemm8_kb(acc, lds, yb, wb, 16);
  const u16* sg = (const u16*)(ws + O_SG) + (size_t)mt * 256 * 2048 + nt * 256;
  u16* mg = (u16*)(ws + O_MERGED) + (size_t)mt * 32 * 8192;
  uint2 gp[4][4], tp[4][4];
  epi8<2>(acc, [&](int m, int ni, int r, int c) { gp[m][ni] = *(const uint2*)(sg + (size_t)r * 2048 + 1024 + c); },
       [&](int m, int, int ni, int r, int c, f32x4& v) {
         f32x4 gb = unpk4(gp[m][ni]);
         *(uint2*)(mg + kb32(r, nt * 256 + c, 1024)) = pk4(v * gb);
       });
  zero_acc8(acc);
  const u16* ya = (const u16*)(ws + O_HBUF) + (size_t)mt * 32 * 8192;
  const u16* wa = (const u16*)(ws + O_WAT) + (size_t)nt * 32 * 8192;
  gemm8_kb(acc, lds, ya, wa, 32);
  epi8<2>(acc,
       [&](int m, int ni, int r, int c) {
         gp[m][ni] = *(const uint2*)(sg + (size_t)r * 2048 + c);
         tp[m][ni] = *(const uint2*)(mg + kb32(r, nt * 256 + c, 1024));
       },
       [&](int m, int, int ni, int r, int c, f32x4& v) {
         f32x4 ga = unpk4(gp[m][ni]), tt = unpk4(tp[m][ni]);
         *(uint2*)(mg + kb32(r, nt * 256 + c, 1024)) = pk4(v * ga + tt);
       });
}
DEVI void b_phase10(const P& p, char* lds, int t) {
  const int tid = tidx512(), lane = tid & 63, wid = tid >> 6, wr = wid >> 2, wc = wid & 3, fr = lane & 15, fq = lane >> 4;
  char* ws = p.ws;
  int mt = t >> 2, nt = t & 3;
  const u16* mg = (const u16*)(ws + O_MERGED) + (size_t)mt * 32 * 8192;
  const u16* wo = (const u16*)(ws + O_WOT) + (size_t)nt * 32 * 8192;
  f32x4 acc[8][4]; zero_acc8(acc);
  gemm8_kb(acc, lds, mg, wo, 32);
  float* rq = (float*)(ws + O_RSQP);
#pragma unroll
  for (int mg2 = 0; mg2 < 8; ++mg2) {
    float sq = 0.f;
#pragma unroll
    for (int ni = 0; ni < 4; ++ni) { f32x4 v = acc[mg2][ni]; sq += v[0] * v[0] + v[1] * v[1] + v[2] * v[2] + v[3] * v[3]; }
    sq = red_fq(sq);
    if (fq == 0) rq[(size_t)(mt * 256 + wr * 128 + mg2 * 16 + fr) * 16 + nt * 4 + wc] = sq;
  }
  asm volatile("s_waitcnt vmcnt(0)" ::: "memory");
  __syncthreads();
  if (threadIdx.x == 0) {
    unsigned* cnt = (unsigned*)(ws + O_BAR + 32768) + mt * 16;
    unsigned* bar = (unsigned*)(ws + O_BAR);
    __builtin_amdgcn_fence(__ATOMIC_RELEASE, "agent");
    asm volatile("s_waitcnt vmcnt(0)" ::: "memory");
    xb_add(cnt, 1u);
    XB_SPIN(xb_ld(cnt) < 4u, bar);
    __builtin_amdgcn_fence(__ATOMIC_ACQUIRE, "agent");
    asm volatile("s_waitcnt vmcnt(0)" ::: "memory");
  }
  __syncthreads();
  float rstd[8];
#pragma unroll
  for (int mg2 = 0; mg2 < 8; ++mg2) {
    const float* q = rq + (size_t)(mt * 256 + wr * 128 + mg2 * 16 + fr) * 16;
    float4 a = *(const float4*)(q), b = *(const float4*)(q + 4), c = *(const float4*)(q + 8), d = *(const float4*)(q + 12);
    float ss = ((a.x + a.y) + (a.z + a.w)) + ((b.x + b.y) + (b.z + b.w)) + ((c.x + c.y) + (c.z + c.w)) + ((d.x + d.y) + (d.z + d.w));
    rstd[mg2] = rsqrtf(ss * (1.f / 1024.f) + 1e-6f);
  }
  const float* xb_ = p.x + (size_t)mt * 256 * 1024 + nt * 256;
  float* ob = p.out + (size_t)mt * 256 * 1024 + nt * 256;
  float4 xpre[2][4]; f32x4 gpre[4];
  epi8<2>(acc,
       [&](int m, int ni, int r, int c) {
         { f32x4 tx = __builtin_nontemporal_load((const f32x4*)(xb_ + (size_t)r * 1024 + c)); xpre[m][ni] = make_float4(tx[0], tx[1], tx[2], tx[3]); }
         if (m == 0) gpre[ni] = *(const f32x4*)(p.norm_post_g + nt * 256 + c);
       },
       [&](int m, int mg2, int ni, int r, int c, f32x4& v) {
         float4 xv = xpre[m][ni]; f32x4 g = gpre[ni]; float rs = rstd[mg2];
         f32x4 ov = {xv.x + v[0] * rs * g[0], xv.y + v[1] * rs * g[1], xv.z + v[2] * rs * g[2], xv.w + v[3] * rs * g[3]};
         __builtin_nontemporal_store(ov, (f32x4*)(ob + (size_t)r * 1024 + c));
       });
}

DEVI int big_tiles_per_wg(int NT, int nb) { return nb == 256 ? (16 * NT + 31) / 32 : (128 * NT + nb - 1) / nb; }
DEVI int big_tile(int i, int NT, int bid, int nb) {
  if (nb == 256) {
    const int x = bid & 7, sl = bid >> 3, l = sl + 32 * i;
    if (l >= 16 * NT) return -1;
    return (x * 16 + l / NT) * NT + (l % NT);
  }
  const int t = bid + i * nb;
  return t < 128 * NT ? t : -1;
}
__global__ void __launch_bounds__(512, 2) mega(P p) {
  __shared__ __attribute__((aligned(16))) char lds_all[131072];
  __shared__ uint4 xb_words;
  if (threadIdx.x == 0) xb_words = make_uint4(0u, 0u, 0u, 0u);
  __syncthreads();
  XcdBarrier xb = xcd_barrier_post((unsigned*)(p.ws + O_BAR), (volatile LAS unsigned*)&xb_words);
  const int vb = __builtin_amdgcn_readfirstlane(threadIdx.x >> 8);
  char* lds = lds_all + vb * 65536;
  const int nb = gridDim.x, bid = blockIdx.x;
  const int nb2 = nb * 2, bid2 = bid * 2 + vb;
  {
    bool gw = false;
    for (int t0 = bid2; t0 < T0_ALL * (1 + ((DUP >> 0) & 1)); t0 += nb2) {
      const int t = t0 % T0_ALL;
      if (t < T0_ALL - T0_NORM) gw = false;
      if (!gw && t >= T0_ALL - T0_NORM) {
        gw = true;
        __syncthreads();
        const int k4 = tidx() * 4;
        float w[4][8];
#pragma unroll
        for (int e = 0; e < 4; ++e) {
          const float* wrow = p.w_in + (size_t)(k4 + e) * 6152 + 3072;
          float4 a = *(const float4*)(wrow), b = *(const float4*)(wrow + 4);
          w[e][0] = a.x; w[e][1] = a.y; w[e][2] = a.z; w[e][3] = a.w; w[e][4] = b.x; w[e][5] = b.y; w[e][6] = b.z; w[e][7] = b.w;
        }
#pragma unroll
        for (int q = 0; q < 8; ++q) *(float4*)((float*)lds + q * 1024 + k4) = make_float4(w[0][q], w[1][q], w[2][q], w[3][q]);
        __syncthreads();
      }
      phase0(p, lds, t);
    }
  }
  xcd_barrier(xb);
  for (int i = 0; i < big_tiles_per_wg(6, nb); ++i) { const int t = big_tile(i, 6, bid, nb); if (t >= 0) b_phase1(p, lds_all, t); }
  for (int t = bid2; t < 256; t += nb2) gate_pass1(p, t);
  xcd_barrier(xb);
  if (nb2 == 512) {
    if (bid2 < 128) phase2(p, lds, T2_GATE + bid2);
    else if (bid2 < 384) phase2(p, lds, bid2 - 128);
    if (bid2 < 128) { phase2(p, lds, T2_GATE + T2_E + bid2); phase2(p, lds, T2_GATE + T2_E + 128 + bid2); }
    else for (int t = 256 + (bid2 - 128); t < T2_V; t += 384) phase2(p, lds, T2_GATE + T2_E + t);
    phase2(p, lds, T2_GATE + T2_E + T2_V + bid2);
  } else {
    for (int t = bid2; t < T2_ALL; t += nb2) phase2(p, lds, t);
  }
  xcd_barrier(xb);
  if (nb2 == 512) {
    if (bid2 < 32) phase3(p, lds, bid2);
    phase3(p, lds, T3_SCAN + bid2);
    if (bid2 < 32) { for (int i = 0; i < 4; ++i) phase3(p, lds, T3_SCAN + T3_CA + bid2 + 32 * i); }
    else for (int t = 128 + (bid2 - 32); t < T3_QK; t += 480) phase3(p, lds, T3_SCAN + T3_CA + t);
  } else {
    for (int t = bid2; t < T3_ALL; t += nb2) phase3(p, lds, t);
  }
  xcd_barrier(xb);
  for (int task = bid; task < 256; task += nb) cstate64_task(p, lds_all, task, vb);
  if (nb2 == 512 && !((DUP >> 4) & 1)) {
    phase4(p, lds, bid2);
    phase4(p, lds, 1023 - bid2);
  } else {
    for (int t = bid2; t < T4_TOEP * (1 + ((DUP >> 4) & 1)); t += nb2) phase4(p, lds, t % T4_TOEP);
  }
  for (int t = bid2; t < 16; t += nb2) nscan_tile(p, lds, t);
  xcd_barrier(xb);
  for (int i = 0; i < big_tiles_per_wg(2, nb); ++i) { const int t = big_tile(i, 2, bid, nb); if (t >= 0) b_glu(p, lds_all, t); }
  for (int i = 0; i < big_tiles_per_wg(4, nb); ++i) {
    const int t = big_tile(i, 4, bid, nb);
    if (t >= 0) {
      const int mt = t >> 2, hd = t & 3, bh = (mt >> 5) * 4 + hd, c0 = (mt & 31) * 2;
      phase6(p, lds, (bh << 6) | (c0 + vb));
      phase7(p, lds, (bh << 7) | (c0 << 1) | vb);
      phase7(p, lds, (bh << 7) | ((c0 + 1) << 1) | vb);
      b_phase75(p, lds_all, t);
      b_phase8(p, lds_all, t);
    }
  }
  xcd_barrier(xb);
  for (int i = 0; i < big_tiles_per_wg(4, nb); ++i) {
    const int t = big_tile(i, 4, bid, nb);
    if (t >= 0) {
      const int mt = t >> 2, nt = t & 3;
      b_phase85(p, lds_all, mt * 8 + nt);
      b_phase85(p, lds_all, mt * 8 + nt + 4);
      b_phase9(p, lds_all, t);
    }
  }
  xcd_barrier(xb);
  for (int i = 0; i < big_tiles_per_wg(4, nb); ++i) { const int t = big_tile(i, 4, bid, nb); if (t >= 0) b_phase10(p, lds_all, t); }
}

extern "C" void kernel_launch(void* const* d_in, const int* in_sizes, int n_in, void* d_out, int out_size, void* d_ws,
                              size_t ws_size, hipStream_t stream) {
  if (ws_size < O_END) { fprintf(stderr, "workspace too small: %zu < %zu\n", ws_size, (size_t)O_END); return; }
  static int grid_blocks = 0;
  if (!grid_blocks) {
    int dev = 0, cus = 0, per_cu = 0;
    hipGetDevice(&dev);
    hipDeviceGetAttribute(&cus, hipDeviceAttributeMultiprocessorCount, dev);
    hipOccupancyMaxActiveBlocksPerMultiprocessor(&per_cu, mega, 512, 0);
    if (per_cu > 1) per_cu = 1;
    grid_blocks = cus * per_cu;
  }
  P p{};
  const float** pp = (const float**)&p;
  for (int i = 0; i < 26; ++i) pp[i] = (const float*)d_in[i];
  p.out = (float*)d_out;
  p.ws = (char*)d_ws;
  hipMemsetAsync((char*)d_ws + O_BAR, 0, 32768 + 128 * 64, stream);
  void* args[] = {&p};
  hipError_t e = hipLaunchCooperativeKernel((void*)mega, dim3(grid_blocks), dim3(512), args, 0, stream);
  if (e != hipSuccess) fprintf(stderr, "cooperative launch failed: %s (grid %d)\n", hipGetErrorString(e), grid_blocks);
}
```
